# Optimizing an MI355X kernel written in HIP

```python
import jax, jax.numpy as jnp
from jax import lax
import numpy as np

D_MODEL = 2048
BATCH = 4
SEQ = 4096
DEPTH = 4

CHUNK = 64
EPS = 1e-6
D_PLE = 256
D_FF = 5632
SGU_BLOCK = 128
D_A = 1024
N_GROUPS_A = 8
DG_A = D_A // N_GROUPS_A
D_B = 512
CONV_W = 3
D_C = 512
POOL_WINDOWS = (2, 4, 8, 16)
N_GROUPS_C = len(POOL_WINDOWS)
DG_C = D_C // N_GROUPS_C
N_BRANCH = 3
D_MIX = D_A + D_B + D_C
N_IN = 2 * D_A + 3 * D_B + D_C + N_BRANCH * D_MODEL

kernel_name = "hybrid_gmlp_shortconv_pool_macaron_trunk"


def _rmsnorm(x, g):
    xf = x.astype(jnp.float32)
    y = xf * lax.rsqrt(jnp.mean(xf * xf, axis=-1, keepdims=True) + EPS)
    return y.astype(x.dtype) * g


def _layernorm(x, g, b):
    xf = x.astype(jnp.float32)
    mu = jnp.mean(xf, axis=-1, keepdims=True)
    var = jnp.mean(jnp.square(xf - mu), axis=-1, keepdims=True)
    y = (xf - mu) * lax.rsqrt(var + EPS)
    return y.astype(x.dtype) * g + b


def _swiglu(x, w_gate, w_up, w_down):
    return (jax.nn.silu(x @ w_gate) * (x @ w_up)) @ w_down


def _sgu_mixer(z, sgu_norm_g, sgu_norm_b, sgu_w, sgu_b):
    bsz, seq, _ = z.shape
    u, v = z[..., :D_A], z[..., D_A:]
    v = _layernorm(v, sgu_norm_g, sgu_norm_b)
    v = v.reshape(bsz, seq // SGU_BLOCK, SGU_BLOCK, N_GROUPS_A, DG_A)
    pos = jnp.arange(SGU_BLOCK)
    mask = (pos[None, :] // CHUNK) <= (pos[:, None] // CHUNK)
    w = jnp.where(mask[None], sgu_w, jnp.zeros_like(sgu_w))
    vm = jnp.einsum('gts,bnsgc->bntgc', w, v) + jnp.transpose(sgu_b)[:, :, None]
    return u * vm.reshape(bsz, seq, D_A)


def _short_conv_mixer(zb, conv_w):
    b_gate, c_gate, xin = zb[..., :D_B], zb[..., D_B:2 * D_B], zb[..., 2 * D_B:]
    y = c_gate * xin
    y = lax.conv_general_dilated(
        y, conv_w[:, None, :].astype(y.dtype), window_strides=(1,), padding=[(CONV_W - 1, 0)],
        dimension_numbers=('NWC', 'WIO', 'NWC'), feature_group_count=D_B)
    return b_gate * y


def _pool_mixer(xc, pool_w, pool_scale):
    bsz, seq, _ = xc.shape
    xf = xc.astype(jnp.float32)
    cs = jnp.pad(jnp.cumsum(xf, axis=1), ((0, 0), (1, 0), (0, 0)))
    t1 = jnp.arange(1, seq + 1, dtype=jnp.float32)
    outs = []
    for g, w in enumerate(POOL_WINDOWS):
        csg = cs[:, :, g * DG_C:(g + 1) * DG_C]
        hi = csg[:, 1:]
        lo = jnp.pad(csg[:, :seq + 1 - w], ((0, 0), (w - 1, 0), (0, 0)))
        cnt = jnp.minimum(t1, jnp.float32(w))[None, :, None]
        outs.append((hi - lo) / cnt)
    pooled = (jnp.concatenate(outs, axis=-1) - xf).astype(xc.dtype)
    pooled = pooled.reshape(bsz, seq, N_GROUPS_C, DG_C)
    y = jnp.einsum('bsgc,gcd->bsgd', pooled, pool_w).reshape(bsz, seq, D_C)
    return y * pool_scale


def _layer(x, p_i, ffn1_norm, ffn1_w_gate, ffn1_w_up, ffn1_w_down, mix_norm, w_in, sgu_norm_g, sgu_norm_b,
           sgu_w, sgu_b, conv_w, pool_w, pool_scale, w_branch_a, w_branch_b, w_branch_c, w_out,
           ffn2_norm, ffn2_w_gate, ffn2_w_up, ffn2_w_down, ple_norm, ple_w_gate, ple_w_proj):
    bsz, seq, _ = x.shape
    h = x + 0.5 * _swiglu(_rmsnorm(x, ffn1_norm), ffn1_w_gate, ffn1_w_up, ffn1_w_down)
    n = _rmsnorm(h, mix_norm)
    z = n @ w_in
    o1 = 2 * D_A
    o2 = o1 + 3 * D_B
    o3 = o2 + D_C
    ya = _sgu_mixer(jax.nn.gelu(z[..., :o1], approximate=False), sgu_norm_g, sgu_norm_b, sgu_w, sgu_b)
    yb = _short_conv_mixer(z[..., o1:o2], conv_w)
    yc = _pool_mixer(z[..., o2:o3], pool_w, pool_scale)
    gates = jax.nn.sigmoid(z[..., o3:]).reshape(bsz, seq, N_BRANCH, D_MODEL)
    m = (gates[:, :, 0] * (ya @ w_branch_a)
         + gates[:, :, 1] * (yb @ w_branch_b)
         + gates[:, :, 2] * (yc @ w_branch_c))
    h = h + m @ w_out
    h = h + 0.5 * _swiglu(_rmsnorm(h, ffn2_norm), ffn2_w_gate, ffn2_w_up, ffn2_w_down)
    h = h + jax.nn.sigmoid(_rmsnorm(h, ple_norm) @ ple_w_gate) * (p_i @ ple_w_proj)
    return h


def setup_inputs(seed: int = 0) -> dict:
    key = jax.random.key(seed)
    ks = iter(jax.random.split(key, 40))
    L, D, F = DEPTH, D_MODEL, D_FF

    def nrm(shape, scale):
        return jax.random.normal(next(ks), shape, jnp.float32) * scale

    def gain(shape):
        return 1.0 + nrm(shape, 0.01)

    return {
        "x": nrm((BATCH, SEQ, D), 1.0),
        "p": nrm((L, BATCH, SEQ, D_PLE), 1.0),
        "ffn1_norm": gain((L, D)),
        "ffn1_w_gate": nrm((L, D, F), D ** -0.5),
        "ffn1_w_up": nrm((L, D, F), D ** -0.5),
        "ffn1_w_down": nrm((L, F, D), F ** -0.5),
        "mix_norm": gain((L, D)),
        "w_in": nrm((L, D, N_IN), D ** -0.5),
        "sgu_norm_g": gain((L, D_A)),
        "sgu_norm_b": nrm((L, D_A), 0.01),
        "sgu_w": nrm((L, N_GROUPS_A, SGU_BLOCK, SGU_BLOCK), SGU_BLOCK ** -0.5),
        "sgu_b": gain((L, N_GROUPS_A, SGU_BLOCK)),
        "conv_w": nrm((L, CONV_W, D_B), CONV_W ** -0.5),
        "pool_w": nrm((L, N_GROUPS_C, DG_C, DG_C), DG_C ** -0.5),
        "pool_scale": gain((L, D_C)),
        "w_branch_a": nrm((L, D_A, D), D_A ** -0.5),
        "w_branch_b": nrm((L, D_B, D), D_B ** -0.5),
        "w_branch_c": nrm((L, D_C, D), D_C ** -0.5),
        "w_out": nrm((L, D, D), D ** -0.5),
        "ffn2_norm": gain((L, D)),
        "ffn2_w_gate": nrm((L, D, F), D ** -0.5),
        "ffn2_w_up": nrm((L, D, F), D ** -0.5),
        "ffn2_w_down": nrm((L, F, D), F ** -0.5),
        "ple_norm": gain((L, D)),
        "ple_w_gate": nrm((L, D, D), D ** -0.5),
        "ple_w_proj": nrm((L, D_PLE, D), D_PLE ** -0.5),
        "final_norm": gain((D,)),
    }


def reference(x, p, ffn1_norm, ffn1_w_gate, ffn1_w_up, ffn1_w_down, mix_norm, w_in, sgu_norm_g, sgu_norm_b,
              sgu_w, sgu_b, conv_w, pool_w, pool_scale, w_branch_a, w_branch_b, w_branch_c, w_out,
              ffn2_norm, ffn2_w_gate, ffn2_w_up, ffn2_w_down, ple_norm, ple_w_gate, ple_w_proj, final_norm):
    h = x
    for i in range(DEPTH):
        h = _layer(h, p[i], ffn1_norm[i], ffn1_w_gate[i], ffn1_w_up[i], ffn1_w_down[i], mix_norm[i], w_in[i],
                   sgu_norm_g[i], sgu_norm_b[i], sgu_w[i], sgu_b[i], conv_w[i], pool_w[i], pool_scale[i],
                   w_branch_a[i], w_branch_b[i], w_branch_c[i], w_out[i], ffn2_norm[i], ffn2_w_gate[i],
                   ffn2_w_up[i], ffn2_w_down[i], ple_norm[i], ple_w_gate[i], ple_w_proj[i])
    return _rmsnorm(h, final_norm)
```

```cpp
#include <hip/hip_runtime.h>
#include <cstdio>
#include <cstdint>
namespace pg8 {
#define PG8_LAS __attribute__((address_space(3)))
typedef unsigned short bf16_t;
typedef short bf16x8 __attribute__((ext_vector_type(8)));
typedef float f32x4 __attribute__((ext_vector_type(4)));
typedef float f32x2 __attribute__((ext_vector_type(2)));
typedef unsigned u32x4 __attribute__((ext_vector_type(4)));
typedef unsigned u32x2 __attribute__((ext_vector_type(2)));
constexpr int BM = 256, BK = 64, HALF = 128, HTB = HALF * BK * 2  , STAGE_BYTES = 8 * HTB, NXCD = 8, WGM = 8;

__host__ __device__ __forceinline__ int lds_byte(int r, int c) { const int st = (r >> 4) * 2 + (c >> 5), rr = r & 15, cc = c & 31, ob = rr * 64 + cc * 2; return st * 1024 + (ob ^ (((ob >> 9) & 1) << 5)); }
__host__ __device__ __forceinline__ void stage_rc(int b, int& R, int& C) { const int st = b / 1024, sb = b % 1024, swz = sb ^ (((sb >> 9) & 1) << 5); R = (st >> 1) * 16 + swz / 64; C = (st & 1) * 32 + (swz % 64) / 2; }
__host__ __device__ __forceinline__ int perm32(int rho) { const int n = rho >> 4, i = rho & 15; return 8 * (i >> 2) + 4 * n + (i & 3); }

struct Unit { const char* A; const char* B; int nt; int pm, pn, kind; };

struct TileOrder {
    int nM, nN, nwg, G, c;
    __host__ __device__ void init(int M, int N, int G_, int c_) { nM = M / BM; nN = N / BM; nwg = nM * nN; G = G_; c = c_; }
    __host__ __device__ bool tile(int i, int& pm, int& pn) const {
        const long L = (long)i * G + c; if (L >= nwg) return false;
        int wgid = (int)L; { const int q = nwg / NXCD, r = nwg % NXCD, xcd = wgid % NXCD, off = wgid / NXCD; wgid = (xcd < r ? xcd * (q + 1) : r * (q + 1) + (xcd - r) * q) + off; }
        const int nig = WGM * nN, gid = wgid / nig, fm = gid * WGM, gsz = (nM - fm) < WGM ? (nM - fm) : WGM;
        pm = fm + ((wgid % nig) % gsz); pn = (wgid % nig) / gsz; return true;
    }
};

__device__ __forceinline__ unsigned cvt_pk_bf16(float lo, float hi) { unsigned r; asm volatile("v_cvt_pk_bf16_f32 %0, %1, %2" : "=v"(r) : "v"(lo), "v"(hi)); return r; }
__device__ __forceinline__ f32x2 gelu_pk(f32x2 v) {
    const f32x2 av = __builtin_elementwise_abs(v), d = av * 0.2316418882f + 1.0f;
    f32x2 t; t.x = __builtin_amdgcn_rcpf(d.x); t.y = __builtin_amdgcn_rcpf(d.y);
    f32x2 q = t * 0.5307027145f + (-0.7265760135f); q = q * t + 0.7107068705f; q = q * t + (-0.142248368f); q = q * t + 0.127414796f; q = q * t;
    const f32x2 s = (v * v) * (-0.72134752044f);
    f32x2 e; e.x = __builtin_amdgcn_exp2f(s.x); e.y = __builtin_amdgcn_exp2f(s.y);
    const f32x2 m = v * (q * e), r = v - m;
    f32x2 o; o.x = v.x < 0.f ? m.x : r.x; o.y = v.y < 0.f ? m.y : r.y; return o;
}

template <class Epi, class Sched>
__device__ __forceinline__ void gemm_phase(PG8_LAS unsigned char* lds, const int lda, const int ldb, const Sched& S, const Epi& E) {
    int tid_ = threadIdx.x; asm volatile("" : "+v"(tid_));
    const int tid = tid_, wid = __builtin_amdgcn_readfirstlane(tid >> 6), lane = tid & 63, wr = wid >> 2, wc = wid & 3, fr = lane & 15, fq = lane >> 4;
    unsigned voffA[2], voffB[2];
#pragma unroll
    for (int i = 0; i < 2; ++i) { int R, C; stage_rc(tid * 16 + i * 8192, R, C); const int Rb = (R & ~31) + perm32(R & 31);
        voffA[i] = (unsigned)(R * lda + C) * 2u; voffB[i] = (unsigned)(Rb * ldb + C) * 2u; }
    const size_t kstep = (size_t)(BK * 2);
    const size_t hstepA = (size_t)HALF * lda * 2, hstepB = (size_t)HALF * ldb * 2;
    const unsigned ldsw = (unsigned)wid * 1024u;
    const int aoff = lds_byte(wr * 64 + fr, fq * 8), boff = lds_byte(wc * 32 + fr, fq * 8);
#define PG8_SA(b, h) (((b) * 2 + (h)) * HTB)
#define PG8_SB(b, h) ((4 + (b) * 2 + (h)) * HTB)
#define PG8_STAGE(bufoff, gbase, voff) do { _Pragma("unroll") for (int _i = 0; _i < 2; ++_i) \
        __builtin_amdgcn_global_load_lds((const unsigned*)((const char*)(gbase) + (voff)[_i]), (PG8_LAS unsigned*)(lds + (bufoff) + ldsw + _i * 8192), 16, 0, 0); } while (0)
#define PG8_LDA(dst, b, h) do { _Pragma("unroll") for (int m = 0; m < 4; ++m) _Pragma("unroll") for (int k = 0; k < 2; ++k) dst[m][k] = *(const PG8_LAS bf16x8*)(lds + PG8_SA(b, h) + aoff + m * 2048 + k * 1024); } while (0)
#define PG8_LDB(dst, b, h) do { _Pragma("unroll") for (int n = 0; n < 2; ++n) _Pragma("unroll") for (int k = 0; k < 2; ++k) dst[n][k] = *(const PG8_LAS bf16x8*)(lds + PG8_SB(b, h) + boff + n * 2048 + k * 1024); } while (0)
#define PG8_MMA(ai, bj, At, Bt) do { __builtin_amdgcn_s_setprio(1); _Pragma("unroll") for (int m = 0; m < 4; ++m) _Pragma("unroll") for (int n = 0; n < 2; ++n) _Pragma("unroll") for (int k = 0; k < 2; ++k) \
        acc[ai][bj][m][n] = __builtin_amdgcn_mfma_f32_16x16x32_bf16(Bt[n][k], At[m][k], acc[ai][bj][m][n], 0, 0, 0); __builtin_amdgcn_s_setprio(0); } while (0)
#define PG8_WAIT_V(n) asm volatile("s_waitcnt vmcnt(" #n ")" ::: "memory")
#define PG8_WAIT_L(n) asm volatile("s_waitcnt lgkmcnt(" #n ")" ::: "memory")
#define PG8_BAR __builtin_amdgcn_s_barrier()
#define PG8_SCHED __builtin_amdgcn_sched_barrier(0)
    Unit cur, nxt; int ui = 0;
    if (!S.next(0, cur)) return;
    f32x4 acc[2][2][4][2];
#pragma unroll
    for (int a = 0; a < 2; ++a)
#pragma unroll
        for (int b = 0; b < 2; ++b)
#pragma unroll
            for (int m = 0; m < 4; ++m)
#pragma unroll
                for (int n = 0; n < 2; ++n) acc[a][b][m][n] = (f32x4){0.f, 0.f, 0.f, 0.f};
    bf16x8 At[4][2], B0[2][2], B1[2][2];
    const char* cA = cur.A; const char* cB = cur.B;
    PG8_STAGE(PG8_SB(0, 0), cB, voffB); PG8_STAGE(PG8_SB(0, 1), cB + hstepB, voffB); PG8_STAGE(PG8_SA(0, 0), cA, voffA); PG8_STAGE(PG8_SA(0, 1), cA + hstepA, voffA);
    if (wr == 1) PG8_BAR;
    PG8_WAIT_V(2); PG8_BAR;
    PG8_STAGE(PG8_SB(1, 0), cB + kstep, voffB); PG8_STAGE(PG8_SA(1, 0), cA + kstep, voffA); PG8_STAGE(PG8_SB(1, 1), cB + hstepB + kstep, voffB);
    PG8_WAIT_V(6); PG8_BAR;
    for (;;) {
        const bool has_next = S.next(ui + 1, nxt);
        const char* nA = has_next ? nxt.A : cA; const char* nB = has_next ? nxt.B : cB;
        const int nt = cur.nt;
        for (int t = 0; t < nt; t += 2) {
            const bool last = (t == nt - 2);
            const char* a1 = cA + (size_t)(t + 1) * kstep;
            const char* a2 = last ? nA : cA + (size_t)(t + 2) * kstep; const char* b2 = last ? nB : cB + (size_t)(t + 2) * kstep;
            const char* a3 = a2 + kstep; const char* b3 = b2 + kstep;
            PG8_LDB(B0, 0, 0); PG8_LDB(B1, 0, 1); PG8_SCHED; PG8_LDA(At, 0, 0); PG8_STAGE(PG8_SA(1, 1), a1 + hstepA, voffA);
            PG8_WAIT_V(8); PG8_WAIT_L(0); PG8_BAR; PG8_MMA(0, 0, At, B0); PG8_MMA(0, 1, At, B1); PG8_BAR; PG8_SCHED;
            PG8_LDA(At, 0, 1); PG8_STAGE(PG8_SB(0, 0), b2, voffB); PG8_STAGE(PG8_SB(0, 1), b2 + hstepB, voffB); PG8_STAGE(PG8_SA(0, 0), a2, voffA);
            PG8_WAIT_V(8); PG8_WAIT_L(0); PG8_BAR; PG8_MMA(1, 0, At, B0); PG8_MMA(1, 1, At, B1); PG8_BAR; PG8_SCHED;
            PG8_LDB(B0, 1, 0); PG8_LDB(B1, 1, 1); PG8_SCHED; PG8_LDA(At, 1, 0); PG8_STAGE(PG8_SA(0, 1), a2 + hstepA, voffA);
            PG8_WAIT_V(8); PG8_WAIT_L(0); PG8_BAR; PG8_MMA(0, 0, At, B0); PG8_MMA(0, 1, At, B1); PG8_BAR; PG8_SCHED;
            PG8_LDA(At, 1, 1); PG8_STAGE(PG8_SB(1, 0), b3, voffB); PG8_STAGE(PG8_SB(1, 1), b3 + hstepB, voffB); PG8_STAGE(PG8_SA(1, 0), a3, voffA);
            PG8_WAIT_V(8); PG8_WAIT_L(0); PG8_BAR; PG8_MMA(1, 0, At, B0); PG8_MMA(1, 1, At, B1); PG8_BAR; PG8_SCHED;
        }
        if (wr == 0) PG8_BAR;
        E(acc, cur, wr, wc, fr, fq);
        if (!has_next) break;
#pragma unroll
        for (int a = 0; a < 2; ++a)
#pragma unroll
            for (int b = 0; b < 2; ++b)
#pragma unroll
                for (int m = 0; m < 4; ++m)
#pragma unroll
                    for (int n = 0; n < 2; ++n) acc[a][b][m][n] = (f32x4){0.f, 0.f, 0.f, 0.f};
        cur = nxt; cA = nA; cB = nB; ++ui;
        if (wr == 1) PG8_BAR;
    }
    PG8_WAIT_V(0);
    PG8_BAR;
#undef PG8_SA
#undef PG8_SB
#undef PG8_STAGE
#undef PG8_LDA
#undef PG8_LDB
#undef PG8_MMA
#undef PG8_WAIT_V
#undef PG8_WAIT_L
#undef PG8_BAR
#undef PG8_SCHED
}
}
constexpr int NWAVES = 8;
constexpr int BATCH = 4, SEQ = 4096, D = 2048, DEPTH = 4, FF = 5632, NIN = 10240, DPLE = 256;
constexpr int M = BATCH * SEQ;
constexpr float EPS = 1e-6f;
constexpr size_t MiB = 1u << 20;
constexpr size_t WS_CTL = 0, CTL_ZERO_BYTES = 4 * MiB;
constexpr size_t WS_W = 4 * MiB;
constexpr size_t OW_GU1 = 0, OW_D1 = 44 * MiB, OW_IN = 66 * MiB, OW_BR = 106 * MiB, OW_OUT = 114 * MiB, OW_GU2 = 122 * MiB, OW_D2 = 166 * MiB, OW_P = 188 * MiB, OW_SGU = 197 * MiB, OW_POOL = 197 * MiB + 512 * 1024, LAYER_W = 198 * MiB;
constexpr size_t WS_ZH = WS_W + DEPTH * LAYER_W;
constexpr size_t WS_HB = WS_ZH + 320 * MiB;
constexpr size_t WS_PCAT = WS_HB + 64 * MiB;
constexpr size_t WS_YCAT = WS_PCAT + 64 * MiB;
constexpr size_t WS_MB = WS_YCAT + 64 * MiB;
constexpr size_t WS_MTMP = WS_MB + 64 * MiB;
constexpr size_t WS_HB2 = WS_MTMP + 128 * MiB;
constexpr size_t WS_END = WS_HB2 + 64 * MiB;
constexpr int CW_BAR = 4096;
constexpr size_t SS_OFF = 1 * MiB;
static_assert(SS_OFF + (size_t)17 * M * 8 <= CTL_ZERO_BYTES, "CTL words inside the memset region");
typedef unsigned long long u64;
constexpr float SS_SCALE = 1048576.0f, SS_INV = 1.0f / 1048576.0f;
constexpr int RING_OFF = 0, RING_BYTES = 131072;
constexpr int LDSCTL_OFF = RING_BYTES, MISC_OFF = LDSCTL_OFF + 320;
constexpr int LDS_BYTES = 147456;
static_assert(MISC_OFF + 128 <= LDS_BYTES, "LDS map");

#define GAS __attribute__((address_space(1)))
#define LAS __attribute__((address_space(3)))
typedef unsigned short bf16;
typedef unsigned v4u __attribute__((ext_vector_type(4)));
typedef unsigned v2u __attribute__((ext_vector_type(2)));
typedef float f32x4 __attribute__((ext_vector_type(4)));
typedef float f32x2 __attribute__((ext_vector_type(2)));
typedef short bf16x8 __attribute__((ext_vector_type(8)));
typedef GAS unsigned gu32;
#define RLX_AGENT __ATOMIC_RELAXED, __HIP_MEMORY_SCOPE_AGENT
#define LDS_WAIT() asm volatile("s_waitcnt lgkmcnt(0)" ::: "memory")
#define VM_WAIT() asm volatile("s_waitcnt vmcnt(0)" ::: "memory")
__device__ __forceinline__ unsigned f2bf(float f) { unsigned u = __builtin_bit_cast(unsigned, f); return (u + 0x7fffu + ((u >> 16) & 1u)) >> 16; }
__device__ __forceinline__ unsigned pk2(float lo, float hi) { return f2bf(lo) | (f2bf(hi) << 16); }
__device__ __forceinline__ float bflo(unsigned w) { return __builtin_bit_cast(float, w << 16); }
__device__ __forceinline__ float bfhi(unsigned w) { return __builtin_bit_cast(float, w & 0xffff0000u); }
__device__ __forceinline__ float fast_sigmoid(float x) { return __builtin_amdgcn_rcpf(1.0f + __builtin_amdgcn_exp2f(-1.44269504089f * x)); }
__device__ __forceinline__ float wave_sum(float v) {
#pragma unroll
    for (int o = 1; o < 64; o <<= 1) v += __shfl_xor(v, o);
    return v;
}
#define XB_TMO      128
#define XB_XCNT(j)  (256  + 64 * (j))
#define XB_XSUB(j)  (1280 + 64 * (j))
#define XB_XGEN(j)  (2304 + 64 * (j))
#define XB_TOP      3328
#define XB_TOPGEN   3392
#define XCD_BAR_WORDS 3456
#define XB_SPIN_CAP (1u << 18)

__device__ __forceinline__ unsigned xb_ld(unsigned* p)              { return __hip_atomic_load(p, __ATOMIC_RELAXED, __HIP_MEMORY_SCOPE_AGENT); }
__device__ __forceinline__ unsigned xb_add(unsigned* p, unsigned v) { return __hip_atomic_fetch_add(p, v, __ATOMIC_RELAXED, __HIP_MEMORY_SCOPE_AGENT); }
__device__ __forceinline__ unsigned xb_xcc_id() { return (unsigned)__builtin_amdgcn_s_getreg((3 << 11) | 20) & 0xFu; }
#define XB_SPIN(cond, bar) do { unsigned _sp = 0; while (cond) { __builtin_amdgcn_s_sleep(1); \
    if ((++_sp & 255u) == 0u) { if (xb_ld(&(bar)[XB_TMO])) break; if (_sp > XB_SPIN_CAP) { atomicAdd(&(bar)[XB_TMO], 1u); break; } } } } while (0)

struct XcdBarrier {
    unsigned* bar; unsigned x;
    volatile LAS unsigned* st;
};

__device__ __forceinline__ XcdBarrier xcd_barrier_post(unsigned* bar, volatile LAS unsigned* st) {
    XcdBarrier b; b.bar = bar; b.x = xb_xcc_id(); b.st = st;
    if (threadIdx.x == 0) (void)xb_add(&bar[XB_XCNT(b.x)], 1u);
    return b;
}
__device__ __forceinline__ void xcd_barrier_complete(unsigned* bar, unsigned x, unsigned& nloc, unsigned& nx) {
    const unsigned G = gridDim.x * gridDim.y * gridDim.z;
    unsigned sum, cnt, mine, sp = 0u;
    for (;;) {
        sum = 0u; cnt = 0u; mine = 0u;
#pragma unroll
        for (unsigned j = 0; j < 16; ++j) { const unsigned c = xb_ld(&bar[XB_XCNT(j)]); sum += c; cnt += (c > 0u) ? 1u : 0u; mine = (j == x) ? c : mine; }
        if (sum == G) break;
        __builtin_amdgcn_s_sleep(1);
        if ((++sp & 255u) == 0u) { if (xb_ld(&bar[XB_TMO])) break; if (sp > XB_SPIN_CAP) { atomicAdd(&bar[XB_TMO], 1u); break; } }
    }
    nloc = mine > 0u ? mine : 1u; nx = cnt > 0u ? cnt : 1u;
}

__device__ __forceinline__ void xcd_barrier(const XcdBarrier& b) {
    asm volatile("s_waitcnt vmcnt(0)" ::: "memory");
    __syncthreads();
    if (threadIdx.x == 0) {
        unsigned* bar = b.bar;
        __builtin_amdgcn_s_waitcnt(0);
        unsigned nloc = b.st[0], nx = b.st[1];
        if (nloc == 0u) { xcd_barrier_complete(bar, b.x, nloc, nx); b.st[0] = nloc; b.st[1] = nx; }
        const unsigned old = xb_add(&bar[XB_XSUB(b.x)], 1u);
        const unsigned gen = old / nloc;
        if (old + 1u == (gen + 1u) * nloc) {
            __builtin_amdgcn_fence(__ATOMIC_RELEASE, "agent");
            asm volatile("s_waitcnt vmcnt(0)" ::: "memory");
            const unsigned og = xb_add(&bar[XB_TOP], 1u);
            const unsigned tg = og / nx;
            if (og + 1u == (tg + 1u) * nx) xb_add(&bar[XB_TOPGEN], 1u);
            else XB_SPIN(xb_ld(&bar[XB_TOPGEN]) == tg, bar);
            __builtin_amdgcn_fence(__ATOMIC_ACQUIRE, "agent");
            xb_add(&bar[XB_XGEN(b.x)], 1u);
            asm volatile("s_waitcnt vmcnt(0)" ::: "memory");
        } else {
            XB_SPIN(xb_ld(&bar[XB_XGEN(b.x)]) == gen, bar);
            __builtin_amdgcn_fence(__ATOMIC_ACQUIRE, "agent");
            asm volatile("s_waitcnt vmcnt(0)" ::: "memory");
        }
    }
    __syncthreads();
}

struct Frame {
    LAS unsigned char* lds;
    volatile LAS unsigned* MISC;
    gu32* ctl;
    int tid, lane, wave;
    int vcu, G;
};

__device__ __forceinline__ void xpose_item(const float* __restrict__ W, int ldw, const float* __restrict__ gv, bf16* __restrict__ WT, int dpitch, int drow, int dk, int k0, int n0, LAS float* scr, int lane) {
#pragma unroll 8
    for (int i = 0; i < 32; ++i) { const int kk = 2 * i + (lane >> 5); float w = W[(size_t)(k0 + kk) * ldw + n0 + (lane & 31)]; if (gv) w *= gv[k0 + kk]; scr[kk * 33 + (lane & 31)] = w; }
    LDS_WAIT(); asm volatile("" ::: "memory");
    const int c = lane & 7;
#pragma unroll
    for (int j = 0; j < 4; ++j) { const int n = (lane >> 3) + 8 * j; const LAS float* s = scr + (8 * c) * 33 + n;
        v4u o; o.x = pk2(s[0 * 33], s[1 * 33]); o.y = pk2(s[2 * 33], s[3 * 33]); o.z = pk2(s[4 * 33], s[5 * 33]); o.w = pk2(s[6 * 33], s[7 * 33]);
        *(GAS v4u*)(WT + (size_t)(drow + n) * dpitch + dk + k0 + 8 * c) = o; }
    LDS_WAIT(); asm volatile("" ::: "memory");
}
template <int MODE>
__device__ __forceinline__ void xpose_mat(const float* W, int K, int N, const float* gv, bf16* WT, int dpitch, int dk, int item, LAS float* scr, int lane) {
    const int nblk = N / 32, kb = item / nblk, nbk = item % nblk, n0 = 32 * nbk;
    const int drow = (MODE == 0) ? n0 : (256 * (n0 >> 7) + 128 * (MODE - 1) + (n0 & 127));
    xpose_item(W, N, gv, WT, dpitch, drow, dk, 64 * kb, n0, scr, lane);
}
struct InPtrs { const float* p[27]; };
constexpr int IT_GU = (D / 64) * (FF / 32), IT_DN = (FF / 64) * (D / 32), IT_IN = (D / 64) * (NIN / 32), IT_BA = (1024 / 64) * (D / 32), IT_BB = (512 / 64) * (D / 32),
              IT_DD = (D / 64) * (D / 32), IT_PP = (DPLE / 64) * (D / 32), IT_PL = 4 * 2 * 4;
constexpr int IT_LAYER = 4 * IT_GU + 2 * IT_DN + IT_IN + IT_BA + 2 * IT_BB + 2 * IT_DD + IT_PP + IT_PL;
__device__ __forceinline__ void p0_prologue(Frame& F, const InPtrs& I, unsigned char* ws, u64* ss0) {
    LAS float* scr = (LAS float*)(F.lds + RING_OFF + F.wave * 16384);
    const int gw = F.vcu * NWAVES + F.wave, NGW = F.G * NWAVES, lane = F.lane;
    for (int it = gw; it < DEPTH * IT_LAYER; it += NGW) {
        const int l = it / IT_LAYER; int r = it % IT_LAYER;
        unsigned char* wl = ws + WS_W + (size_t)l * LAYER_W;
        if (r < IT_GU) { xpose_mat<1>(I.p[3] + (size_t)l * D * FF, D, FF, I.p[2] + l * D, (bf16*)(wl + OW_GU1), D, 0, r, scr, lane); continue; } r -= IT_GU;
        if (r < IT_GU) { xpose_mat<2>(I.p[4] + (size_t)l * D * FF, D, FF, I.p[2] + l * D, (bf16*)(wl + OW_GU1), D, 0, r, scr, lane); continue; } r -= IT_GU;
        if (r < IT_DN) { xpose_mat<0>(I.p[5] + (size_t)l * FF * D, FF, D, nullptr, (bf16*)(wl + OW_D1), FF, 0, r, scr, lane); continue; } r -= IT_DN;
        if (r < IT_IN) { xpose_mat<0>(I.p[7] + (size_t)l * D * NIN, D, NIN, I.p[6] + l * D, (bf16*)(wl + OW_IN), D, 0, r, scr, lane); continue; } r -= IT_IN;
        if (r < IT_BA) { xpose_mat<0>(I.p[15] + (size_t)l * 1024 * D, 1024, D, nullptr, (bf16*)(wl + OW_BR), D, 0, r, scr, lane); continue; } r -= IT_BA;
        if (r < IT_BB) { xpose_mat<0>(I.p[16] + (size_t)l * 512 * D, 512, D, nullptr, (bf16*)(wl + OW_BR), D, 1024, r, scr, lane); continue; } r -= IT_BB;
        if (r < IT_BB) { xpose_mat<0>(I.p[17] + (size_t)l * 512 * D, 512, D, nullptr, (bf16*)(wl + OW_BR), D, 1536, r, scr, lane); continue; } r -= IT_BB;
        if (r < IT_DD) { xpose_mat<0>(I.p[18] + (size_t)l * D * D, D, D, nullptr, (bf16*)(wl + OW_OUT), D, 0, r, scr, lane); continue; } r -= IT_DD;
        if (r < IT_GU) { xpose_mat<1>(I.p[20] + (size_t)l * D * FF, D, FF, I.p[19] + l * D, (bf16*)(wl + OW_GU2), D, 0, r, scr, lane); continue; } r -= IT_GU;
        if (r < IT_GU) { xpose_mat<2>(I.p[21] + (size_t)l * D * FF, D, FF, I.p[19] + l * D, (bf16*)(wl + OW_GU2), D, 0, r, scr, lane); continue; } r -= IT_GU;
        if (r < IT_DN) { xpose_mat<0>(I.p[22] + (size_t)l * FF * D, FF, D, nullptr, (bf16*)(wl + OW_D2), FF, 0, r, scr, lane); continue; } r -= IT_DN;
        if (r < IT_DD) { xpose_mat<0>(I.p[24] + (size_t)l * D * D, D, D, I.p[23] + l * D, (bf16*)(wl + OW_P), D + DPLE, 0, r, scr, lane); continue; } r -= IT_DD;
        if (r < IT_PP) { xpose_mat<0>(I.p[25] + (size_t)l * DPLE * D, DPLE, D, nullptr, (bf16*)(wl + OW_P), D + DPLE, D, r, scr, lane); continue; } r -= IT_PP;
        { const int g = r / 8, rr = r % 8; xpose_mat<0>(I.p[13] + ((size_t)l * 4 + g) * 128 * 128, 128, 128, nullptr, (bf16*)(wl + OW_POOL) + (size_t)g * 128 * 128, 128, 0, rr, scr, lane); }
    }
    const size_t gt = (size_t)F.vcu * (NWAVES * 64) + F.tid, GT = (size_t)F.G * NWAVES * 64;
    for (size_t i = gt; i < (size_t)DEPTH * 8 * 128 * 128 / 8; i += GT) {
        const size_t e0 = i * 8; const int l = (int)(e0 / (8 * 128 * 128)), rem = (int)(e0 % (8 * 128 * 128)), t = (rem / 128) % 128, s0 = rem % 128;
        const f32x4 a = *(const GAS f32x4*)(I.p[10] + e0), b = *(const GAS f32x4*)(I.p[10] + e0 + 4);
        v4u o; if ((s0 >> 6) <= (t >> 6)) { o.x = pk2(a.x, a.y); o.y = pk2(a.z, a.w); o.z = pk2(b.x, b.y); o.w = pk2(b.z, b.w); } else { o = (v4u){0u, 0u, 0u, 0u}; }
        *(GAS v4u*)((bf16*)(ws + WS_W + (size_t)l * LAYER_W + OW_SGU) + rem) = o; }
    for (size_t i = gt; i < (size_t)DEPTH * M * DPLE / 8; i += GT) {
        const size_t e0 = i * 8; const int l = (int)(e0 / ((size_t)M * DPLE)); const size_t rem = e0 % ((size_t)M * DPLE); const int m = (int)(rem / DPLE), j = (int)(rem % DPLE);
        const f32x4 a = *(const GAS f32x4*)(I.p[1] + e0), b = *(const GAS f32x4*)(I.p[1] + e0 + 4);
        v4u o; o.x = pk2(a.x, a.y); o.y = pk2(a.z, a.w); o.z = pk2(b.x, b.y); o.w = pk2(b.z, b.w);
        *(GAS v4u*)((bf16*)(ws + WS_PCAT) + (size_t)m * D + l * DPLE + j) = o; }
    for (int m = gw; m < M; m += NGW) {
        const float* xr = I.p[0] + (size_t)m * D; bf16* hr = (bf16*)(ws + WS_HB2) + (size_t)m * D; float s = 0.f;
#pragma unroll
        for (int j = 0; j < 4; ++j) { const f32x4 a = *(const GAS f32x4*)(xr + 512 * j + 8 * lane), b = *(const GAS f32x4*)(xr + 512 * j + 8 * lane + 4);
            s += (a.x * a.x + a.y * a.y) + (a.z * a.z + a.w * a.w) + (b.x * b.x + b.y * b.y) + (b.z * b.z + b.w * b.w);
            v4u o; o.x = pk2(a.x, a.y); o.y = pk2(a.z, a.w); o.z = pk2(b.x, b.y); o.w = pk2(b.z, b.w); *(GAS v4u*)(hr + 512 * j + 8 * lane) = o; }
        s = wave_sum(s); if (lane == 0) ss0[m] = (u64)(s * SS_SCALE + 0.5f);
    }
}

struct SchedPlain {
    pg8::TileOrder T; const char* A; const char* B; size_t astep, bstep; int nt;
    __device__ __forceinline__ bool next(int i, pg8::Unit& u) const { int pm, pn; if (!T.tile(i, pm, pn)) return false; u.pm = pm; u.pn = pn; u.kind = 0; u.A = A + (size_t)pm * astep; u.B = B + (size_t)pn * bstep; u.nt = nt; return true; }
};
struct SchedBranch {
    pg8::TileOrder T; const char* A; const char* B; size_t astep, bstep;
    __device__ __forceinline__ bool next(int i, pg8::Unit& u) const { int pm, pn; const int ti = i / 3, sub = i - 3 * ti; if (!T.tile(ti, pm, pn)) return false; u.pm = pm; u.pn = pn; u.kind = sub;
        const size_t ko = sub == 0 ? 0 : (sub == 1 ? 2048 : 3072); u.A = A + (size_t)pm * astep + ko; u.B = B + (size_t)pn * bstep + ko; u.nt = sub == 0 ? 16 : 8; return true; }
};
struct SchedPle {
    pg8::TileOrder T; const char* Ap; const char* Ah; const char* B; size_t astep, bstep;
    __device__ __forceinline__ bool next(int i, pg8::Unit& u) const { int pm, pn; const int ti = i >> 1, sub = i & 1; if (!T.tile(ti, pm, pn)) return false; u.pm = pm; u.pn = pn; u.kind = sub;
        u.A = (sub == 0 ? Ap : Ah) + (size_t)pm * astep; u.B = B + (size_t)pn * bstep + (sub == 0 ? (size_t)D * 2 : 0); u.nt = sub == 0 ? DPLE / 64 : D / 64; return true; }
};

typedef pg8::f32x4 A4;
__device__ __forceinline__ v4u pack8(const A4& a, const A4& b) { v4u w; w.x = pg8::cvt_pk_bf16(a[0], a[1]); w.y = pg8::cvt_pk_bf16(a[2], a[3]); w.z = pg8::cvt_pk_bf16(b[0], b[1]); w.w = pg8::cvt_pk_bf16(b[2], b[3]); return w; }
__device__ __forceinline__ float rinv_of(const u64* ss, int row) { return 1.0f / sqrtf((float)ss[row] * (SS_INV / (float)D) + EPS); }
__device__ __forceinline__ void ss_add(u64* ss, int row, float q) { (void)__hip_atomic_fetch_add(ss + row, (u64)(q * SS_SCALE + 0.5f), __ATOMIC_RELAXED, __HIP_MEMORY_SCOPE_AGENT); }

struct EpiSwiglu {
    bf16* hid; const u64* ss;
    __device__ __forceinline__ void operator()(const A4 (&acc)[2][2][4][2], const pg8::Unit& u, int wr, int wc, int fr, int fq) const {
        const int row0 = u.pm * 256 + wr * 64 + fr, col0 = u.pn * 128 + wc * 32 + 8 * fq;
#pragma unroll
        for (int ai = 0; ai < 2; ++ai)
#pragma unroll
            for (int m = 0; m < 4; ++m) { const int row = row0 + ai * 128 + m * 16; const float ri = rinv_of(ss, row);
                A4 o[2];
#pragma unroll
                for (int n = 0; n < 2; ++n) { const A4 g = acc[ai][0][m][n] * ri, up = acc[ai][1][m][n] * ri;
#pragma unroll
                    for (int j = 0; j < 4; ++j) o[n][j] = g[j] * fast_sigmoid(g[j]) * up[j]; }
                *(GAS v4u*)(hid + (size_t)row * FF + col0) = pack8(o[0], o[1]); }
    }
};
struct EpiResid {
    const float* hin; float* hout; bf16* hb; float scale; u64* ssout;
    __device__ __forceinline__ void operator()(const A4 (&acc)[2][2][4][2], const pg8::Unit& u, int wr, int wc, int fr, int fq) const {
        const int row0 = u.pm * 256 + wr * 64 + fr, col0 = u.pn * 256 + wc * 32 + 8 * fq;
#pragma unroll
        for (int ai = 0; ai < 2; ++ai)
#pragma unroll
            for (int m = 0; m < 4; ++m) { const int row = row0 + ai * 128 + m * 16; float q = 0.f;
#pragma unroll
                for (int bj = 0; bj < 2; ++bj) { const size_t off = (size_t)row * D + col0 + bj * 128;
                    const A4 o0 = *(const GAS A4*)(hin + off), o1 = *(const GAS A4*)(hin + off + 4);
                    const A4 v0 = o0 + acc[ai][bj][m][0] * scale, v1 = o1 + acc[ai][bj][m][1] * scale;
                    *(GAS A4*)(hout + off) = v0; *(GAS A4*)(hout + off + 4) = v1; *(GAS v4u*)(hb + off) = pack8(v0, v1);
                    q += (v0[0] * v0[0] + v0[1] * v0[1]) + (v0[2] * v0[2] + v0[3] * v0[3]) + (v1[0] * v1[0] + v1[1] * v1[1]) + (v1[2] * v1[2] + v1[3] * v1[3]); }
                q += __shfl_xor(q, 16); q += __shfl_xor(q, 32);
                if (fq == 0) ss_add(ssout, row, q);
                asm volatile("" ::: "memory"); }
    }
};
struct EpiWin {
    bf16* z; const u64* ss;
    __device__ __forceinline__ void operator()(const A4 (&acc)[2][2][4][2], const pg8::Unit& u, int wr, int wc, int fr, int fq) const {
        const int row0 = u.pm * 256 + wr * 64 + fr, col0 = u.pn * 256 + wc * 32 + 8 * fq; const int act = u.pn < 8 ? 1 : (u.pn < 16 ? 0 : 2);
#pragma unroll
        for (int ai = 0; ai < 2; ++ai)
#pragma unroll
            for (int m = 0; m < 4; ++m) { const int row = row0 + ai * 128 + m * 16; const float ri = rinv_of(ss, row);
#pragma unroll
                for (int bj = 0; bj < 2; ++bj) { A4 v0 = acc[ai][bj][m][0] * ri, v1 = acc[ai][bj][m][1] * ri;
                    if (act == 1) { const f32x2 a = pg8::gelu_pk((f32x2){v0[0], v0[1]}), b = pg8::gelu_pk((f32x2){v0[2], v0[3]}), c = pg8::gelu_pk((f32x2){v1[0], v1[1]}), d = pg8::gelu_pk((f32x2){v1[2], v1[3]});
                        v0 = (A4){a.x, a.y, b.x, b.y}; v1 = (A4){c.x, c.y, d.x, d.y}; }
                    else if (act == 2) {
#pragma unroll
                        for (int j = 0; j < 4; ++j) { v0[j] = fast_sigmoid(v0[j]); v1[j] = fast_sigmoid(v1[j]); } }
                    *(GAS v4u*)(z + (size_t)row * NIN + col0 + bj * 128) = pack8(v0, v1); } }
    }
};
struct EpiBranch {
    const bf16* z; float* mtmp; bf16* mb;
    __device__ __forceinline__ void operator()(const A4 (&acc)[2][2][4][2], const pg8::Unit& u, int wr, int wc, int fr, int fq) const {
        const int row0 = u.pm * 256 + wr * 64 + fr, col0 = u.pn * 256 + wc * 32 + 8 * fq; const int kind = u.kind;
#pragma unroll
        for (int ai = 0; ai < 2; ++ai)
#pragma unroll
            for (int m = 0; m < 4; ++m) { const int row = row0 + ai * 128 + m * 16;
#pragma unroll
                for (int bj = 0; bj < 2; ++bj) { const size_t off = (size_t)row * D + col0 + bj * 128;
                    const v4u gw = *(const GAS v4u*)(z + (size_t)row * NIN + 4096 + kind * 2048 + col0 + bj * 128);
                    A4 v0 = acc[ai][bj][m][0] * (A4){bflo(gw.x), bfhi(gw.x), bflo(gw.y), bfhi(gw.y)}, v1 = acc[ai][bj][m][1] * (A4){bflo(gw.z), bfhi(gw.z), bflo(gw.w), bfhi(gw.w)};
                    if (kind != 0) { v0 += *(const GAS A4*)(mtmp + off); v1 += *(const GAS A4*)(mtmp + off + 4); }
                    if (kind != 2) { *(GAS A4*)(mtmp + off) = v0; *(GAS A4*)(mtmp + off + 4) = v1; }
                    else *(GAS v4u*)(mb + off) = pack8(v0, v1); }
                asm volatile("" ::: "memory"); }
    }
};
struct EpiPle {
    float* h; bf16* hb; float* tmp; const u64* ss; u64* ssout;
    __device__ __forceinline__ void operator()(const A4 (&acc)[2][2][4][2], const pg8::Unit& u, int wr, int wc, int fr, int fq) const {
        const int row0 = u.pm * 256 + wr * 64 + fr, col0 = u.pn * 256 + wc * 32 + 8 * fq; const int kind = u.kind;
#pragma unroll
        for (int ai = 0; ai < 2; ++ai)
#pragma unroll
            for (int m = 0; m < 4; ++m) { const int row = row0 + ai * 128 + m * 16;
                if (kind == 0) {
#pragma unroll
                    for (int bj = 0; bj < 2; ++bj) { const size_t off = (size_t)row * D + col0 + bj * 128; *(GAS A4*)(tmp + off) = acc[ai][bj][m][0]; *(GAS A4*)(tmp + off + 4) = acc[ai][bj][m][1]; }
                } else { const float ri = rinv_of(ss, row); float q = 0.f;
#pragma unroll
                    for (int bj = 0; bj < 2; ++bj) { const size_t off = (size_t)row * D + col0 + bj * 128;
                        const A4 o0 = *(const GAS A4*)(h + off), o1 = *(const GAS A4*)(h + off + 4), t0 = *(const GAS A4*)(tmp + off), t1 = *(const GAS A4*)(tmp + off + 4);
                        A4 g0 = acc[ai][bj][m][0] * ri, g1 = acc[ai][bj][m][1] * ri;
#pragma unroll
                        for (int j = 0; j < 4; ++j) { g0[j] = fast_sigmoid(g0[j]); g1[j] = fast_sigmoid(g1[j]); }
                        const A4 v0 = o0 + g0 * t0, v1 = o1 + g1 * t1;
                        *(GAS A4*)(h + off) = v0; *(GAS A4*)(h + off + 4) = v1; *(GAS v4u*)(hb + off) = pack8(v0, v1);
                        q += (v0[0] * v0[0] + v0[1] * v0[1]) + (v0[2] * v0[2] + v0[3] * v0[3]) + (v1[0] * v1[0] + v1[1] * v1[1]) + (v1[2] * v1[2] + v1[3] * v1[3]); }
                    q += __shfl_xor(q, 16); q += __shfl_xor(q, 32);
                    if (fq == 0) ss_add(ssout, row, q); }
                asm volatile("" ::: "memory"); }
    }
};

constexpr int TP = 136;
__device__ __forceinline__ void unpack8(const v4u w, float (&f)[8]) { f[0] = bflo(w.x); f[1] = bfhi(w.x); f[2] = bflo(w.y); f[3] = bfhi(w.y); f[4] = bflo(w.z); f[5] = bfhi(w.z); f[6] = bflo(w.w); f[7] = bfhi(w.w); }
__device__ __forceinline__ void mixer_phase(Frame& F, const bf16* __restrict__ z, bf16* __restrict__ ycat, const float* __restrict__ ng, const float* __restrict__ nbias, const bf16* __restrict__ sguw,
                                            const float* __restrict__ sgub, const float* __restrict__ convw, const bf16* __restrict__ poolwt, const float* __restrict__ pscale) {
    LAS f32x2* stats = (LAS f32x2*)(F.lds + RING_OFF);
    LAS bf16* tile = (LAS bf16*)(F.lds + RING_OFF + 1024);
    int tid_ = threadIdx.x; asm volatile("" : "+v"(tid_));
    const int tid = tid_, lane = tid & 63, wave = __builtin_amdgcn_readfirstlane(tid >> 6), fr = lane & 15, fq = lane >> 4;
    for (int un = F.vcu; un < 2 * (M / 128); un += F.G) {
        const int nbk = un >> 1, half = un & 1, row0 = nbk * 128;
        for (int tt = 0; tt < 16; ++tt) { const int t = 16 * wave + tt; const bf16* vp = z + (size_t)(row0 + t) * NIN + 1024 + 16 * lane;
            const v4u a = *(const GAS v4u*)vp, b = *(const GAS v4u*)(vp + 8); float f[16];
            { float g[8]; unpack8(a, g); for (int j = 0; j < 8; ++j) f[j] = g[j]; unpack8(b, g); for (int j = 0; j < 8; ++j) f[8 + j] = g[j]; }
            float s = 0.f;
#pragma unroll
            for (int j = 0; j < 16; ++j) s += f[j];
            const float mean = wave_sum(s) * (1.0f / 1024.0f); float q = 0.f;
#pragma unroll
            for (int j = 0; j < 16; ++j) { const float d = f[j] - mean; q += d * d; }
            const float rstd = 1.0f / sqrtf(wave_sum(q) * (1.0f / 1024.0f) + EPS);
            if (lane == 0) stats[t] = (f32x2){mean, rstd}; }
        LDS_WAIT(); __syncthreads();
        for (int gi = 0; gi < 4; ++gi) { const int g = half * 4 + gi;
            { const int s = tid >> 2, cq = tid & 3; const f32x2 st = stats[s];
#pragma unroll
              for (int q = 0; q < 4; ++q) { const int c8 = 8 * cq + 32 * q, ch = g * 128 + c8;
                  const v4u w = *(const GAS v4u*)(z + (size_t)(row0 + s) * NIN + 1024 + ch); float f[8]; unpack8(w, f);
                  const f32x4 g0 = *(const GAS f32x4*)(ng + ch), g1 = *(const GAS f32x4*)(ng + ch + 4), b0 = *(const GAS f32x4*)(nbias + ch), b1 = *(const GAS f32x4*)(nbias + ch + 4);
                  const float gg[8] = {g0.x, g0.y, g0.z, g0.w, g1.x, g1.y, g1.z, g1.w}, bb[8] = {b0.x, b0.y, b0.z, b0.w, b1.x, b1.y, b1.z, b1.w};
#pragma unroll
                  for (int e = 0; e < 8; ++e) tile[(c8 + e) * TP + s] = (bf16)f2bf((f[e] - st.x) * st.y * gg[e] + bb[e]); } }
            LDS_WAIT(); __syncthreads();
            A4 acc[8];
#pragma unroll
            for (int ct = 0; ct < 8; ++ct) acc[ct] = (A4){0.f, 0.f, 0.f, 0.f};
            const int kkmax = (wave < 4) ? 2 : 4;
            for (int kk = 0; kk < kkmax; ++kk) {
                const bf16x8 wf = *(const GAS bf16x8*)(sguw + ((size_t)g * 128 + 16 * wave + fr) * 128 + kk * 32 + 8 * fq);
#pragma unroll
                for (int ct = 0; ct < 8; ++ct) { const bf16x8 vf = *(const LAS bf16x8*)(tile + (ct * 16 + fr) * TP + kk * 32 + 8 * fq);
                    acc[ct] = __builtin_amdgcn_mfma_f32_16x16x32_bf16(vf, wf, acc[ct], 0, 0, 0); } }
            { const int t = 16 * wave + fr, row = row0 + t; const float bias = sgub[g * 128 + t];
#pragma unroll
              for (int ct = 0; ct < 8; ++ct) { const int col = g * 128 + ct * 16 + 4 * fq;
                  const v2u uw = *(const GAS v2u*)(z + (size_t)row * NIN + col);
                  v2u o; o.x = pk2(bflo(uw.x) * (acc[ct][0] + bias), bfhi(uw.x) * (acc[ct][1] + bias)); o.y = pk2(bflo(uw.y) * (acc[ct][2] + bias), bfhi(uw.y) * (acc[ct][3] + bias));
                  *(GAS v2u*)(ycat + (size_t)row * D + col) = o; } }
            LDS_WAIT(); __syncthreads();
        }
        if (half == 0) {
            const int c8 = 8 * lane; float cw[3][8];
#pragma unroll
            for (int k = 0; k < 3; ++k) { const f32x4 a = *(const GAS f32x4*)(convw + k * 512 + c8), b = *(const GAS f32x4*)(convw + k * 512 + c8 + 4);
                cw[k][0] = a.x; cw[k][1] = a.y; cw[k][2] = a.z; cw[k][3] = a.w; cw[k][4] = b.x; cw[k][5] = b.y; cw[k][6] = b.z; cw[k][7] = b.w; }
            float y2[8], y1[8];
            { const int r0 = row0 + 16 * wave, ts = r0 % SEQ;
#pragma unroll
              for (int e = 0; e < 8; ++e) { y2[e] = 0.f; y1[e] = 0.f; }
              if (ts >= 2) { const bf16* zr = z + (size_t)(r0 - 2) * NIN + 2048; float c[8], x[8]; unpack8(*(const GAS v4u*)(zr + 512 + c8), c); unpack8(*(const GAS v4u*)(zr + 1024 + c8), x);
#pragma unroll
                  for (int e = 0; e < 8; ++e) y2[e] = c[e] * x[e]; }
              if (ts >= 1) { const bf16* zr = z + (size_t)(r0 - 1) * NIN + 2048; float c[8], x[8]; unpack8(*(const GAS v4u*)(zr + 512 + c8), c); unpack8(*(const GAS v4u*)(zr + 1024 + c8), x);
#pragma unroll
                  for (int e = 0; e < 8; ++e) y1[e] = c[e] * x[e]; } }
            for (int tt = 0; tt < 16; ++tt) { const int row = row0 + 16 * wave + tt; const bf16* zr = z + (size_t)row * NIN + 2048;
                float b[8], c[8], x[8], o[8]; unpack8(*(const GAS v4u*)(zr + c8), b); unpack8(*(const GAS v4u*)(zr + 512 + c8), c); unpack8(*(const GAS v4u*)(zr + 1024 + c8), x);
#pragma unroll
                for (int e = 0; e < 8; ++e) { const float y0 = c[e] * x[e]; o[e] = b[e] * (cw[0][e] * y2[e] + cw[1][e] * y1[e] + cw[2][e] * y0); y2[e] = y1[e]; y1[e] = y0; }
                v4u w; w.x = pk2(o[0], o[1]); w.y = pk2(o[2], o[3]); w.z = pk2(o[4], o[5]); w.w = pk2(o[6], o[7]);
                *(GAS v4u*)(ycat + (size_t)row * D + 1024 + c8) = w; }
        } else {
            for (int g = 0; g < 4; ++g) { const int w = 2 << g;
                { const int oct = tid & 15, tq = tid >> 4, c8 = 8 * oct;
                  for (int tt = 0; tt < 4; ++tt) { const int t = 4 * tq + tt, row = row0 + t, ts = row % SEQ; float s[8], x0[8];
#pragma unroll
                      for (int e = 0; e < 8; ++e) s[e] = 0.f;
                      const bf16* xp = z + (size_t)row * NIN + 3584 + g * 128 + c8;
                      unpack8(*(const GAS v4u*)xp, x0);
                      const int cnt = (ts + 1 < w) ? ts + 1 : w;
                      for (int j = 0; j < cnt; ++j) { float x[8]; unpack8(*(const GAS v4u*)(xp - (size_t)j * NIN), x);
#pragma unroll
                          for (int e = 0; e < 8; ++e) s[e] += x[e]; }
                      const float ic = 1.0f / (float)cnt; v4u o;
                      o.x = pk2(s[0] * ic - x0[0], s[1] * ic - x0[1]); o.y = pk2(s[2] * ic - x0[2], s[3] * ic - x0[3]); o.z = pk2(s[4] * ic - x0[4], s[5] * ic - x0[5]); o.w = pk2(s[6] * ic - x0[6], s[7] * ic - x0[7]);
                      *(LAS v4u*)(tile + t * TP + c8) = o; } }
                LDS_WAIT(); __syncthreads();
                A4 acc[8];
#pragma unroll
                for (int dt = 0; dt < 8; ++dt) acc[dt] = (A4){0.f, 0.f, 0.f, 0.f};
                for (int kk = 0; kk < 4; ++kk) {
                    const bf16x8 pf = *(const LAS bf16x8*)(tile + (16 * wave + fr) * TP + kk * 32 + 8 * fq);
#pragma unroll
                    for (int dt = 0; dt < 8; ++dt) { const bf16x8 wf = *(const GAS bf16x8*)(poolwt + ((size_t)g * 128 + dt * 16 + fr) * 128 + kk * 32 + 8 * fq);
                        acc[dt] = __builtin_amdgcn_mfma_f32_16x16x32_bf16(wf, pf, acc[dt], 0, 0, 0); } }
                { const int row = row0 + 16 * wave + fr;
#pragma unroll
                  for (int dt = 0; dt < 8; ++dt) { const int dcol = g * 128 + dt * 16 + 4 * fq; const f32x4 sc = *(const GAS f32x4*)(pscale + dcol);
                      v2u o; o.x = pk2(acc[dt][0] * sc.x, acc[dt][1] * sc.y); o.y = pk2(acc[dt][2] * sc.z, acc[dt][3] * sc.w);
                      *(GAS v2u*)(ycat + (size_t)row * D + 1536 + dcol) = o; } }
                LDS_WAIT(); __syncthreads();
            }
        }
        __syncthreads();
    }
}
__device__ __forceinline__ void final_phase(Frame& F, float* h, const float* __restrict__ g) {
    const int gw = F.vcu * NWAVES + F.wave, NGW = F.G * NWAVES, lane = F.lane;
    for (int m = gw; m < M; m += NGW) { float* hr = h + (size_t)m * D; f32x4 v[8]; float s = 0.f;
#pragma unroll
        for (int j = 0; j < 8; ++j) { v[j] = *(const GAS f32x4*)(hr + 256 * j + 4 * lane); s += (v[j].x * v[j].x + v[j].y * v[j].y) + (v[j].z * v[j].z + v[j].w * v[j].w); }
        const float ri = 1.0f / sqrtf(wave_sum(s) * (1.0f / (float)D) + EPS);
#pragma unroll
        for (int j = 0; j < 8; ++j) { const f32x4 gg = *(const GAS f32x4*)(g + 256 * j + 4 * lane); *(GAS f32x4*)(hr + 256 * j + 4 * lane) = v[j] * ri * gg; }
    }
}
struct Args { InPtrs in; float* out; unsigned char* ws; };
#ifndef MK_ONLY
#define MK_ONLY -1
#endif
#define PH(k) (MK_ONLY < 0 || MK_ONLY == (k))
__global__ void __launch_bounds__(NWAVES * 64, 2) mk_fwd(Args args) {
    extern __shared__ __attribute__((aligned(16))) unsigned char lds[];
    Frame F;
    F.lds = (LAS unsigned char*)lds;
    F.MISC = (volatile LAS unsigned*)(F.lds + MISC_OFF);
    F.tid = threadIdx.x; F.lane = F.tid & 63; F.wave = __builtin_amdgcn_readfirstlane(F.tid >> 6);
    F.G = gridDim.x; { const int bx = blockIdx.x; F.vcu = (F.G % 8 == 0) ? (bx % 8) * (F.G / 8) + bx / 8 : bx; }
    unsigned char* ws = args.ws;
    F.ctl = (gu32*)(ws + WS_CTL);
    for (int u = F.tid; u < (LDS_BYTES - LDSCTL_OFF) / 4; u += NWAVES * 64) ((LAS unsigned*)(F.lds + LDSCTL_OFF))[u] = 0u;
    __syncthreads();
    XcdBarrier bar = xcd_barrier_post((unsigned*)(ws + WS_CTL) + CW_BAR, F.MISC + 8);
    u64* const ssb = (u64*)(ws + WS_CTL + SS_OFF);
    float* const out = args.out;
    bf16* const HB = (bf16*)(ws + WS_HB); bf16* const HB2 = (bf16*)(ws + WS_HB2); bf16* const ZH = (bf16*)(ws + WS_ZH); bf16* const YCAT = (bf16*)(ws + WS_YCAT); bf16* const MB = (bf16*)(ws + WS_MB); float* const MTMP = (float*)(ws + WS_MTMP);
    const int G = F.G, ord = (int)blockIdx.x;
    int phase = 0;
#define PHASE_END() do { xcd_barrier(bar); ++phase; } while (0)

    if (PH(0)) p0_prologue(F, args.in, ws, ssb);
    PHASE_END();

    for (int l = 0; l < DEPTH; ++l) {
        const unsigned char* wl = ws + WS_W + (size_t)l * LAYER_W;
        const u64* ss0 = ssb + (size_t)(4 * l) * M; u64* ss1 = ssb + (size_t)(4 * l + 1) * M; u64* ss2 = ssb + (size_t)(4 * l + 2) * M; u64* ss3 = ssb + (size_t)(4 * l + 3) * M; u64* ss4 = ssb + (size_t)(4 * l + 4) * M;
        if (PH(1))
        { SchedPlain S; S.T.init(M, 2 * FF, G, ord); S.A = (const char*)HB2; S.B = (const char*)(wl + OW_GU1); S.astep = (size_t)256 * D * 2; S.bstep = (size_t)256 * D * 2; S.nt = D / 64;
          EpiSwiglu E{ZH, ss0}; pg8::gemm_phase(F.lds + RING_OFF, D, D, S, E); }
        PHASE_END();
        if (PH(2))
        { SchedPlain S; S.T.init(M, D, G, ord); S.A = (const char*)ZH; S.B = (const char*)(wl + OW_D1); S.astep = (size_t)256 * FF * 2; S.bstep = (size_t)256 * FF * 2; S.nt = FF / 64;
          EpiResid E{l == 0 ? args.in.p[0] : out, out, HB, 0.5f, ss1}; pg8::gemm_phase(F.lds + RING_OFF, FF, FF, S, E); }
        PHASE_END();
        if (PH(3))
        { SchedPlain S; S.T.init(M, NIN, G, ord); S.A = (const char*)HB; S.B = (const char*)(wl + OW_IN); S.astep = (size_t)256 * D * 2; S.bstep = (size_t)256 * D * 2; S.nt = D / 64;
          EpiWin E{ZH, ss1}; pg8::gemm_phase(F.lds + RING_OFF, D, D, S, E); }
        PHASE_END();
        if (PH(4))
        mixer_phase(F, ZH, YCAT, args.in.p[8] + l * 1024, args.in.p[9] + l * 1024, (const bf16*)(wl + OW_SGU), args.in.p[11] + l * 1024, args.in.p[12] + l * 1536, (const bf16*)(wl + OW_POOL), args.in.p[14] + l * 512);
        PHASE_END();
        if (PH(5))
        { SchedBranch S; S.T.init(M, D, G, ord); S.A = (const char*)YCAT; S.B = (const char*)(wl + OW_BR); S.astep = (size_t)256 * D * 2; S.bstep = (size_t)256 * D * 2;
          EpiBranch E{ZH, MTMP, MB}; pg8::gemm_phase(F.lds + RING_OFF, D, D, S, E); }
        PHASE_END();
        if (PH(6))
        { SchedPlain S; S.T.init(M, D, G, ord); S.A = (const char*)MB; S.B = (const char*)(wl + OW_OUT); S.astep = (size_t)256 * D * 2; S.bstep = (size_t)256 * D * 2; S.nt = D / 64;
          EpiResid E{out, out, HB, 1.0f, ss2}; pg8::gemm_phase(F.lds + RING_OFF, D, D, S, E); }
        PHASE_END();
        if (PH(7))
        { SchedPlain S; S.T.init(M, 2 * FF, G, ord); S.A = (const char*)HB; S.B = (const char*)(wl + OW_GU2); S.astep = (size_t)256 * D * 2; S.bstep = (size_t)256 * D * 2; S.nt = D / 64;
          EpiSwiglu E{ZH, ss2}; pg8::gemm_phase(F.lds + RING_OFF, D, D, S, E); }
        PHASE_END();
        if (PH(8))
        { SchedPlain S; S.T.init(M, D, G, ord); S.A = (const char*)ZH; S.B = (const char*)(wl + OW_D2); S.astep = (size_t)256 * FF * 2; S.bstep = (size_t)256 * FF * 2; S.nt = FF / 64;
          EpiResid E{out, out, HB, 0.5f, ss3}; pg8::gemm_phase(F.lds + RING_OFF, FF, FF, S, E); }
        PHASE_END();
        if (PH(9))
        { SchedPle S; S.T.init(M, D, G, ord); S.Ap = (const char*)(ws + WS_PCAT) + (size_t)l * DPLE * 2; S.Ah = (const char*)HB; S.B = (const char*)(wl + OW_P); S.astep = (size_t)256 * D * 2; S.bstep = (size_t)256 * (D + DPLE) * 2;
          EpiPle E{out, HB2, MTMP, ss3, ss4}; pg8::gemm_phase(F.lds + RING_OFF, D, D + DPLE, S, E); }
        PHASE_END();
    }
    if (PH(10))
    final_phase(F, out, args.in.p[26]);
#undef PHASE_END
}

extern "C" void kernel_launch(void* const* d_in, const int* in_sizes, int n_in, void* d_out, int out_size, void* d_ws, size_t ws_size, hipStream_t stream) {
    static int grid = 0;
    if (grid == 0) {
        if (n_in != 27 || out_size != M * D || ws_size < WS_END) { fprintf(stderr, "kernel_launch: unexpected shapes: n_in %d out %d ws %zu (need %zu); nothing launched\n", n_in, out_size, ws_size, (size_t)WS_END); grid = -1; return; }
        int dev = 0, cus = 0, per_cu = 0;
        if (hipGetDevice(&dev) != hipSuccess || hipDeviceGetAttribute(&cus, hipDeviceAttributeMultiprocessorCount, dev) != hipSuccess) { fprintf(stderr, "kernel_launch: device query failed\n"); grid = -1; return; }
        if (hipFuncSetAttribute((const void*)mk_fwd, hipFuncAttributeMaxDynamicSharedMemorySize, LDS_BYTES) != hipSuccess) { fprintf(stderr, "kernel_launch: hipFuncSetAttribute failed\n"); grid = -1; return; }
        if (hipOccupancyMaxActiveBlocksPerMultiprocessor(&per_cu, (const void*)mk_fwd, NWAVES * 64, LDS_BYTES) != hipSuccess || per_cu < 1) { fprintf(stderr, "kernel_launch: occupancy query reports %d blocks per CU\n", per_cu); }
        (void)hipGetLastError();
        grid = cus;
    }
    if (grid < 0) return;
    if (hipMemsetAsync((char*)d_ws + WS_CTL, 0, CTL_ZERO_BYTES, stream) != hipSuccess) { fprintf(stderr, "kernel_launch: memset failed\n"); return; }
    Args a{};
    for (int i = 0; i < 27; ++i) a.in.p[i] = (const float*)d_in[i];
    a.out = (float*)d_out; a.ws = (unsigned char*)d_ws;
    hipLaunchKernelGGL(mk_fwd, dim3(grid), dim3(NWAVES * 64), LDS_BYTES, stream, a);
    const hipError_t le = hipPeekAtLastError();
    if (le != hipSuccess) fprintf(stderr, "kernel_launch: launch failed: %s\n", hipGetErrorName(le));
}
```

```cpp
#include <hip/hip_runtime.h>
#include <cstdio>
#include <cstdint>
namespace pg8 {
#define PG8_LAS __attribute__((address_space(3)))
typedef unsigned short bf16_t;
typedef short bf16x8 __attribute__((ext_vector_type(8)));
typedef float f32x4 __attribute__((ext_vector_type(4)));
typedef float f32x2 __attribute__((ext_vector_type(2)));
typedef unsigned u32x4 __attribute__((ext_vector_type(4)));
typedef unsigned u32x2 __attribute__((ext_vector_type(2)));
constexpr int BM = 256, BK = 64, HALF = 128, HTB = HALF * BK * 2  , STAGE_BYTES = 8 * HTB, NXCD = 8, WGM = 8;

__host__ __device__ __forceinline__ int lds_byte(int r, int c) { const int st = (r >> 4) * 2 + (c >> 5), rr = r & 15, cc = c & 31, ob = rr * 64 + cc * 2; return st * 1024 + (ob ^ (((ob >> 9) & 1) << 5)); }
__host__ __device__ __forceinline__ void stage_rc(int b, int& R, int& C) { const int st = b / 1024, sb = b % 1024, swz = sb ^ (((sb >> 9) & 1) << 5); R = (st >> 1) * 16 + swz / 64; C = (st & 1) * 32 + (swz % 64) / 2; }
__host__ __device__ __forceinline__ int perm32(int rho) { const int n = rho >> 4, i = rho & 15; return 8 * (i >> 2) + 4 * n + (i & 3); }

struct Unit { const char* A; const char* B; int nt; int pm, pn, kind, keep; };

struct TileOrder {
    int nM, nN, nwg, G, c, wide;
    __host__ __device__ void init(int M, int N, int G_, int c_) { nM = M / BM; nN = N / BM; nwg = nM * nN; G = G_; c = c_; wide = 0; }
    __host__ __device__ bool tile(int i, int& pm, int& pn) const {
        if (G == 256 && nM == 64) {
            const int L = i * 256 + c; if (L >= nwg) return false;
            const int xl = c & 7, off = i * 32 + (c >> 3);
            if (wide) { const int r = c >> 3, sr = i >> 1;
                if (8 * sr + 8 <= nN) { pm = 8 * xl + 4 * (i & 1) + (r >> 3); pn = 8 * sr + (r & 7); } else { pm = 8 * xl + (r & 7); pn = 8 * sr + (r >> 3); }
                pn += (xl * nN) >> 3; if (pn >= nN) pn -= nN; return true; }
            pm = 8 * xl + (off & 7); pn = (off >> 3) + ((xl * nN) >> 3); if (pn >= nN) pn -= nN; return true;
        }
        const long L = (long)i * G + c; if (L >= nwg) return false;
        int wgid = (int)L; { const int q = nwg / NXCD, r = nwg % NXCD, xcd = wgid % NXCD, off = wgid / NXCD; wgid = (xcd < r ? xcd * (q + 1) : r * (q + 1) + (xcd - r) * q) + off; }
        const int nig = WGM * nN, gid = wgid / nig, fm = gid * WGM, gsz = (nM - fm) < WGM ? (nM - fm) : WGM;
        pm = fm + ((wgid % nig) % gsz); pn = (wgid % nig) / gsz;
        { const int xl = (int)(L % NXCD); pn += (xl * nN) / NXCD; if (pn >= nN) pn -= nN; }
        return true;
    }
};

__device__ __forceinline__ unsigned cvt_pk_bf16(float lo, float hi) { unsigned r; asm volatile("v_cvt_pk_bf16_f32 %0, %1, %2" : "=v"(r) : "v"(lo), "v"(hi)); return r; }
__device__ __forceinline__ f32x2 gelu_pk(f32x2 v) {
    const f32x2 av = __builtin_elementwise_abs(v), d = av * 0.2316418882f + 1.0f;
    f32x2 t; t.x = __builtin_amdgcn_rcpf(d.x); t.y = __builtin_amdgcn_rcpf(d.y);
    f32x2 q = t * 0.5307027145f + (-0.7265760135f); q = q * t + 0.7107068705f; q = q * t + (-0.142248368f); q = q * t + 0.127414796f; q = q * t;
    const f32x2 s = (v * v) * (-0.72134752044f);
    f32x2 e; e.x = __builtin_amdgcn_exp2f(s.x); e.y = __builtin_amdgcn_exp2f(s.y);
    const f32x2 m = v * (q * e), r = v - m;
    f32x2 o; o.x = v.x < 0.f ? m.x : r.x; o.y = v.y < 0.f ? m.y : r.y; return o;
}

__device__ __forceinline__ void gelu_pk4(f32x2 (&v)[4]) {
    f32x2 d[4], s[4], t[4], e[4], q[4];
#pragma unroll
    for (int i = 0; i < 4; ++i) { d[i] = __builtin_elementwise_abs(v[i]) * 0.2316418882f + 1.0f; s[i] = (v[i] * v[i]) * (-0.72134752044f); }
#pragma unroll
    for (int i = 0; i < 4; ++i) { t[i].x = __builtin_amdgcn_rcpf(d[i].x); t[i].y = __builtin_amdgcn_rcpf(d[i].y); e[i].x = __builtin_amdgcn_exp2f(s[i].x); e[i].y = __builtin_amdgcn_exp2f(s[i].y); }
#pragma unroll
    for (int i = 0; i < 4; ++i) q[i] = t[i] * 0.5307027145f + (-0.7265760135f);
#pragma unroll
    for (int i = 0; i < 4; ++i) q[i] = q[i] * t[i] + 0.7107068705f;
#pragma unroll
    for (int i = 0; i < 4; ++i) q[i] = q[i] * t[i] + (-0.142248368f);
#pragma unroll
    for (int i = 0; i < 4; ++i) q[i] = q[i] * t[i] + 0.127414796f;
#pragma unroll
    for (int i = 0; i < 4; ++i) q[i] = (q[i] * t[i]) * e[i];
#pragma unroll
    for (int i = 0; i < 4; ++i) { const f32x2 m = v[i] * q[i], r = v[i] - m; v[i].x = v[i].x < 0.f ? m.x : r.x; v[i].y = v[i].y < 0.f ? m.y : r.y; }
}

typedef int i32x4 __attribute__((ext_vector_type(4)));
template <bool I8> struct AccOf { typedef f32x4 type; };
template <> struct AccOf<true> { typedef i32x4 type; };
template <class Epi, class Sched, bool I8 = false>
__device__ __forceinline__ void gemm_phase(PG8_LAS unsigned char* lds, const int lda, const int ldb, const Sched S, const Epi E, const int kstepA_ = BK * 2) {
    typedef typename AccOf<I8>::type ACC;
    int tid_ = threadIdx.x; asm volatile("" : "+v"(tid_));
    const int tid = tid_, wid = __builtin_amdgcn_readfirstlane(tid >> 6), lane = tid & 63, wr = wid >> 2, wc = wid & 3, fr = lane & 15, fq = lane >> 4;
    unsigned voffA[2], voffB[2];
#pragma unroll
    for (int i = 0; i < 2; ++i) { int R, C; stage_rc(tid * 16 + i * 8192, R, C); const int Rb = (R & ~31) + perm32(R & 31);
        voffA[i] = (unsigned)(R * lda + C) * 2u; voffB[i] = (unsigned)(Rb * ldb + C) * 2u; }
    const size_t kstep = (size_t)(BK * 2), kstepA = (size_t)kstepA_;
    const size_t hstepA = (size_t)HALF * lda * 2, hstepB = (size_t)HALF * ldb * 2;
    const unsigned ldsw = (unsigned)wid * 1024u;
    const int aoff = lds_byte(wr * 64 + fr, fq * 8), boff = lds_byte(wc * 32 + fr, fq * 8);
#define PG8_SA(b, h) (((b) * 2 + (h)) * HTB)
#define PG8_SB(b, h) ((4 + (b) * 2 + (h)) * HTB)
#define PG8_STAGE(bufoff, gbase, voff) do { _Pragma("unroll") for (int _i = 0; _i < 2; ++_i) \
        __builtin_amdgcn_global_load_lds((const unsigned*)((const char*)(gbase) + (voff)[_i]), (PG8_LAS unsigned*)(lds + (bufoff) + ldsw + _i * 8192), 16, 0, 0); } while (0)
#define PG8_LDA(dst, b, h) do { _Pragma("unroll") for (int m = 0; m < 4; ++m) _Pragma("unroll") for (int k = 0; k < 2; ++k) dst[m][k] = *(const PG8_LAS bf16x8*)(lds + PG8_SA(b, h) + aoff + m * 2048 + k * 1024); } while (0)
#define PG8_LDB(dst, b, h) do { _Pragma("unroll") for (int n = 0; n < 2; ++n) _Pragma("unroll") for (int k = 0; k < 2; ++k) dst[n][k] = *(const PG8_LAS bf16x8*)(lds + PG8_SB(b, h) + boff + n * 2048 + k * 1024); } while (0)
#define PG8_MMA(ai, bj, At, Bt) do { __builtin_amdgcn_s_setprio(1); _Pragma("unroll") for (int m = 0; m < 4; ++m) _Pragma("unroll") for (int n = 0; n < 2; ++n) _Pragma("unroll") for (int k = 0; k < 2; ++k) \
        { if constexpr (I8) acc[ai][bj][m][n] = __builtin_amdgcn_mfma_i32_16x16x64_i8(__builtin_bit_cast(i32x4, Bt[n][k]), __builtin_bit_cast(i32x4, At[m][k]), acc[ai][bj][m][n], 0, 0, 0); \
          else acc[ai][bj][m][n] = __builtin_amdgcn_mfma_f32_16x16x32_bf16(Bt[n][k], At[m][k], acc[ai][bj][m][n], 0, 0, 0); } __builtin_amdgcn_s_setprio(0); } while (0)
#define PG8_WAIT_V(n) asm volatile("s_waitcnt vmcnt(" #n ")" ::: "memory")
#define PG8_WAIT_L(n) asm volatile("s_waitcnt lgkmcnt(" #n ")" ::: "memory")
#define PG8_BAR __builtin_amdgcn_s_barrier()
#define PG8_SCHED __builtin_amdgcn_sched_barrier(0)
    Unit cur, nxt; int ui = 0;
    if (!S.next(0, cur)) return;
    ACC acc[2][2][4][2]; const ACC acc_zero = {};
#pragma unroll
    for (int a = 0; a < 2; ++a)
#pragma unroll
        for (int b = 0; b < 2; ++b)
#pragma unroll
            for (int m = 0; m < 4; ++m)
#pragma unroll
                for (int n = 0; n < 2; ++n) acc[a][b][m][n] = acc_zero;
    bf16x8 At[4][2], B0[2][2], B1[2][2];
    const char* cA = cur.A; const char* cB = cur.B;
    PG8_STAGE(PG8_SB(0, 0), cB, voffB); PG8_STAGE(PG8_SB(0, 1), cB + hstepB, voffB); PG8_STAGE(PG8_SA(0, 0), cA, voffA); PG8_STAGE(PG8_SA(0, 1), cA + hstepA, voffA);
    if (wr == 1) PG8_BAR;
    PG8_WAIT_V(2); PG8_BAR;
    PG8_STAGE(PG8_SB(1, 0), cB + kstep, voffB); PG8_STAGE(PG8_SA(1, 0), cA + kstepA, voffA); PG8_STAGE(PG8_SB(1, 1), cB + hstepB + kstep, voffB);
    PG8_WAIT_V(6); PG8_BAR;
    for (;;) {
        const bool has_next = S.next(ui + 1, nxt);
        const char* nA = has_next ? nxt.A : cA; const char* nB = has_next ? nxt.B : cB;
        const int nt = cur.nt;
        for (int t = 0; t < nt; t += 2) {
            const bool last = (t == nt - 2);
            const char* a1 = cA + (size_t)(t + 1) * kstepA;
            const char* a2 = last ? nA : cA + (size_t)(t + 2) * kstepA; const char* b2 = last ? nB : cB + (size_t)(t + 2) * kstep;
            const char* a3 = a2 + kstepA; const char* b3 = b2 + kstep;
            PG8_LDB(B0, 0, 0); PG8_LDB(B1, 0, 1); PG8_SCHED; PG8_LDA(At, 0, 0); PG8_STAGE(PG8_SA(1, 1), a1 + hstepA, voffA);
            PG8_WAIT_V(8); PG8_WAIT_L(0); PG8_BAR; PG8_MMA(0, 0, At, B0); PG8_MMA(0, 1, At, B1); PG8_BAR; PG8_SCHED;
            PG8_LDA(At, 0, 1); PG8_STAGE(PG8_SB(0, 0), b2, voffB); PG8_STAGE(PG8_SB(0, 1), b2 + hstepB, voffB); PG8_STAGE(PG8_SA(0, 0), a2, voffA);
            PG8_WAIT_V(8); PG8_WAIT_L(0); PG8_BAR; PG8_MMA(1, 0, At, B0); PG8_MMA(1, 1, At, B1); PG8_BAR; PG8_SCHED;
            PG8_LDB(B0, 1, 0); PG8_LDB(B1, 1, 1); PG8_SCHED; PG8_LDA(At, 1, 0); PG8_STAGE(PG8_SA(0, 1), a2 + hstepA, voffA);
            PG8_WAIT_V(8); PG8_WAIT_L(0); PG8_BAR; PG8_MMA(0, 0, At, B0); PG8_MMA(0, 1, At, B1); PG8_BAR; PG8_SCHED;
            PG8_LDA(At, 1, 1); PG8_STAGE(PG8_SB(1, 0), b3, voffB); PG8_STAGE(PG8_SB(1, 1), b3 + hstepB, voffB); PG8_STAGE(PG8_SA(1, 0), a3, voffA);
            PG8_WAIT_V(8); PG8_WAIT_L(0); PG8_BAR; PG8_MMA(1, 0, At, B0); PG8_MMA(1, 1, At, B1); PG8_BAR; PG8_SCHED;
        }
        if (wr == 0) PG8_BAR;
        E(acc, cur, wr, wc, fr, fq);
        if (!has_next) break;
        if (!cur.keep) {
#pragma unroll
        for (int a = 0; a < 2; ++a)
#pragma unroll
            for (int b = 0; b < 2; ++b)
#pragma unroll
                for (int m = 0; m < 4; ++m)
#pragma unroll
                    for (int n = 0; n < 2; ++n) acc[a][b][m][n] = acc_zero;
        }
        cur = nxt; cA = nA; cB = nB; ++ui;
        if (wr == 1) PG8_BAR;
    }
    PG8_WAIT_V(0);
    PG8_BAR;
#undef PG8_SA
#undef PG8_SB
#undef PG8_STAGE
#undef PG8_LDA
#undef PG8_LDB
#undef PG8_MMA
#undef PG8_WAIT_V
#undef PG8_WAIT_L
#undef PG8_BAR
#undef PG8_SCHED
}
}
constexpr int NWAVES = 8;
constexpr int BATCH = 4, SEQ = 4096, D = 2048, DEPTH = 4, FF = 5632, NIN = 10240, DPLE = 256;
#ifndef MK_FFP
#define MK_FFP FF
#endif
constexpr int FFP = MK_FFP;
constexpr int ZP = 4096 + 6144 / 2;
constexpr int M = BATCH * SEQ;
constexpr float EPS = 1e-6f;
constexpr size_t MiB = 1u << 20;
constexpr size_t WS_CTL = 0, CTL_ZERO_BYTES = 4 * MiB;
constexpr size_t WS_W = 4 * MiB;
constexpr size_t OW_GU1 = 0, OW_D1 = 44 * MiB, OW_IN = 66 * MiB, OW_BR = 106 * MiB, OW_OUT = 114 * MiB, OW_GU2 = 122 * MiB, OW_D2 = 166 * MiB, OW_P = 188 * MiB, OW_SGU = 197 * MiB, OW_POOL = 197 * MiB + 512 * 1024, LAYER_W = 198 * MiB;
constexpr size_t WS_ZH = WS_W + DEPTH * LAYER_W;
constexpr size_t WS_HBB = WS_ZH + 224 * MiB;
constexpr size_t WS_HB = WS_HBB + 64 * MiB;
constexpr size_t WS_PCAT = WS_HB + 64 * MiB;
constexpr size_t WS_YCAT = WS_PCAT + 64 * MiB;
constexpr size_t WS_MB = WS_YCAT + 64 * MiB;
constexpr size_t WS_MTMP = WS_MB + 64 * MiB;
constexpr size_t WS_HID = WS_MTMP + 64 * MiB;
constexpr size_t WS_HB2 = WS_HID + 176 * MiB;
constexpr size_t WS_HB8 = WS_HB2 + 64 * MiB;
constexpr size_t WS_HB8B = WS_HB8 + 32 * MiB;
constexpr size_t WS_SC = WS_HB8B + 32 * MiB;
constexpr int NGATE = 6144;
constexpr float Q_SIGMAS = 5.0f;
constexpr size_t WS_DUM = WS_SC + 1 * MiB;
#if defined(MK_DUP)
constexpr size_t WS_END = WS_DUM;
#else
constexpr size_t WS_END = WS_DUM;
#endif
constexpr int CW_BAR = 4096;
constexpr size_t SS_OFF = 1 * MiB;
static_assert(SS_OFF + (size_t)18 * M * 8 <= CTL_ZERO_BYTES, "CTL words inside the memset region");
typedef unsigned long long u64;
constexpr float SS_SCALE = 1048576.0f, SS_INV = 1.0f / 1048576.0f;
constexpr int RING_OFF = 0, RING_BYTES = 131072;
constexpr int LDSCTL_OFF = RING_BYTES, MISC_OFF = LDSCTL_OFF + 320;
constexpr int LDS_BYTES = 147456;
static_assert(MISC_OFF + 128 <= LDS_BYTES, "LDS map");

#define GAS __attribute__((address_space(1)))
#define LAS __attribute__((address_space(3)))
typedef unsigned short bf16;
typedef unsigned v4u __attribute__((ext_vector_type(4)));
typedef unsigned v2u __attribute__((ext_vector_type(2)));
typedef float f32x4 __attribute__((ext_vector_type(4)));
typedef float f32x2 __attribute__((ext_vector_type(2)));
typedef short bf16x8 __attribute__((ext_vector_type(8)));
typedef GAS unsigned gu32;
#define RLX_AGENT __ATOMIC_RELAXED, __HIP_MEMORY_SCOPE_AGENT
#define LDS_WAIT() asm volatile("s_waitcnt lgkmcnt(0)" ::: "memory")
#define VM_WAIT() asm volatile("s_waitcnt vmcnt(0)" ::: "memory")
__device__ __forceinline__ unsigned f2bf(float f) { unsigned u = __builtin_bit_cast(unsigned, f); return (u + 0x7fffu + ((u >> 16) & 1u)) >> 16; }
__device__ __forceinline__ unsigned pk2(float lo, float hi) { return f2bf(lo) | (f2bf(hi) << 16); }
__device__ __forceinline__ float bflo(unsigned w) { return __builtin_bit_cast(float, w << 16); }
__device__ __forceinline__ float bfhi(unsigned w) { return __builtin_bit_cast(float, w & 0xffff0000u); }
typedef _Float16 h16x2 __attribute__((ext_vector_type(2)));
__device__ __forceinline__ unsigned pkh2(float lo, float hi) { const h16x2 v = {(_Float16)lo, (_Float16)hi}; return __builtin_bit_cast(unsigned, v); }
__device__ __forceinline__ float hlo(unsigned w) { return (float)__builtin_bit_cast(h16x2, w).x; }
__device__ __forceinline__ float hhi(unsigned w) { return (float)__builtin_bit_cast(h16x2, w).y; }
__device__ __forceinline__ float fast_sigmoid(float x) { return __builtin_amdgcn_rcpf(1.0f + __builtin_amdgcn_exp2f(-1.44269504089f * x)); }
__device__ __forceinline__ float wave_sum(float v) {
#pragma unroll
    for (int o = 1; o < 64; o <<= 1) v += __shfl_xor(v, o);
    return v;
}
#define XB_TMO      128
#define XB_XCNT(j)  (256  + 64 * (j))
#define XB_XSUB(j)  (1280 + 64 * (j))
#define XB_XGEN(j)  (2304 + 64 * (j))
#define XB_TOP      3328
#define XB_TOPGEN   3392
#define XCD_BAR_WORDS 3456
#define XB_SPIN_CAP (1u << 18)

__device__ __forceinline__ unsigned xb_ld(unsigned* p)              { return __hip_atomic_load(p, __ATOMIC_RELAXED, __HIP_MEMORY_SCOPE_AGENT); }
__device__ __forceinline__ unsigned xb_add(unsigned* p, unsigned v) { return __hip_atomic_fetch_add(p, v, __ATOMIC_RELAXED, __HIP_MEMORY_SCOPE_AGENT); }
__device__ __forceinline__ unsigned xb_xcc_id() { return (unsigned)__builtin_amdgcn_s_getreg((3 << 11) | 20) & 0xFu; }
#define XB_SPIN(cond, bar) do { unsigned _sp = 0; while (cond) { __builtin_amdgcn_s_sleep(1); \
    if ((++_sp & 255u) == 0u) { if (xb_ld(&(bar)[XB_TMO])) break; if (_sp > XB_SPIN_CAP) { atomicAdd(&(bar)[XB_TMO], 1u); break; } } } } while (0)

struct XcdBarrier {
    unsigned* bar; unsigned x;
    volatile LAS unsigned* st;
};

__device__ __forceinline__ XcdBarrier xcd_barrier_post(unsigned* bar, volatile LAS unsigned* st) {
    XcdBarrier b; b.bar = bar; b.x = xb_xcc_id(); b.st = st;
    if (threadIdx.x == 0) (void)xb_add(&bar[XB_XCNT(b.x)], 1u);
    return b;
}
__device__ __forceinline__ void xcd_barrier_complete(unsigned* bar, unsigned x, unsigned& nloc, unsigned& nx) {
    const unsigned G = gridDim.x * gridDim.y * gridDim.z;
    unsigned sum, cnt, mine, sp = 0u;
    for (;;) {
        sum = 0u; cnt = 0u; mine = 0u;
#pragma unroll
        for (unsigned j = 0; j < 16; ++j) { const unsigned c = xb_ld(&bar[XB_XCNT(j)]); sum += c; cnt += (c > 0u) ? 1u : 0u; mine = (j == x) ? c : mine; }
        if (sum == G) break;
        __builtin_amdgcn_s_sleep(1);
        if ((++sp & 255u) == 0u) { if (xb_ld(&bar[XB_TMO])) break; if (sp > XB_SPIN_CAP) { atomicAdd(&bar[XB_TMO], 1u); break; } }
    }
    nloc = mine > 0u ? mine : 1u; nx = cnt > 0u ? cnt : 1u;
}

__device__ __forceinline__ void xcd_barrier(const XcdBarrier& b) {
    asm volatile("s_waitcnt vmcnt(0)" ::: "memory");
    __syncthreads();
    if (threadIdx.x == 0) {
        unsigned* bar = b.bar;
        unsigned bx = b.x; asm volatile("" : "+s"(bx));
        __builtin_amdgcn_s_waitcnt(0);
        unsigned nloc = b.st[0], nx = b.st[1];
        if (nloc == 0u) { xcd_barrier_complete(bar, bx, nloc, nx); b.st[0] = nloc; b.st[1] = nx; }
        const unsigned old = xb_add(&bar[XB_XSUB(bx)], 1u);
        const unsigned gen = old / nloc;
        if (old + 1u == (gen + 1u) * nloc) {
            __builtin_amdgcn_fence(__ATOMIC_RELEASE, "agent");
            asm volatile("s_waitcnt vmcnt(0)" ::: "memory");
            const unsigned og = xb_add(&bar[XB_TOP], 1u);
            const unsigned tg = og / nx;
            if (og + 1u == (tg + 1u) * nx) xb_add(&bar[XB_TOPGEN], 1u);
            else XB_SPIN(xb_ld(&bar[XB_TOPGEN]) == tg, bar);
            __builtin_amdgcn_fence(__ATOMIC_ACQUIRE, "agent");
            xb_add(&bar[XB_XGEN(bx)], 1u);
            asm volatile("s_waitcnt vmcnt(0)" ::: "memory");
        } else {
            XB_SPIN(xb_ld(&bar[XB_XGEN(bx)]) == gen, bar);
            __builtin_amdgcn_fence(__ATOMIC_ACQUIRE, "agent");
            asm volatile("s_waitcnt vmcnt(0)" ::: "memory");
        }
    }
    __syncthreads();
}


#define XB_LSUB(j)  (3520 + 64 * (j))
#define XB_LGEN(j)  (4544 + 64 * (j))
#define XCD_BAR_WORDS_EXT 5568
__device__ __forceinline__ void xcd_local_barrier(const XcdBarrier& b) {
    asm volatile("s_waitcnt vmcnt(0)" ::: "memory");
    __syncthreads();
    if (threadIdx.x == 0) {
        unsigned* bar = b.bar;
        unsigned bx = b.x; asm volatile("" : "+s"(bx));
        __builtin_amdgcn_s_waitcnt(0);
        const unsigned nloc = b.st[0];
        const unsigned old = xb_add(&bar[XB_LSUB(bx)], 1u);
        const unsigned gen = old / nloc;
        if (old + 1u == (gen + 1u) * nloc) xb_add(&bar[XB_LGEN(bx)], 1u);
        else XB_SPIN(xb_ld(&bar[XB_LGEN(bx)]) == gen, bar);
        __builtin_amdgcn_fence(__ATOMIC_ACQUIRE, "agent");
        asm volatile("s_waitcnt vmcnt(0)" ::: "memory");
    }
    __syncthreads();
}
struct Frame {
    LAS unsigned char* lds;
    volatile LAS unsigned* MISC;
    gu32* ctl;
    int tid, lane, wave;
    int vcu, G;
};

struct XItem { const float* W; const float* gv; bf16* WT; int ldw, dpitch, k0, n0; };
__device__ __forceinline__ void xitem_load(const XItem& x, int lane, f32x4 (&v)[8], float (&g)[8]) {
    const int kr = lane >> 3, n4 = (lane & 7) * 4;
#pragma unroll
    for (int i = 0; i < 8; ++i) { v[i] = *(const GAS f32x4*)(x.W + (size_t)(x.k0 + 8 * i + kr) * x.ldw + x.n0 + n4); g[i] = x.gv ? x.gv[x.k0 + 8 * i + kr] : 1.0f; }
}
__device__ __forceinline__ void xitem_store(const XItem& x, int lane, const f32x4 (&v)[8], const float (&g)[8], LAS float* scr) {
    const int kr = lane >> 3, n4 = (lane & 7) * 4;
#pragma unroll
    for (int i = 0; i < 8; ++i) { LAS float* s = scr + (8 * i + kr) * 33 + n4; s[0] = v[i].x * g[i]; s[1] = v[i].y * g[i]; s[2] = v[i].z * g[i]; s[3] = v[i].w * g[i]; }
    LDS_WAIT(); asm volatile("" ::: "memory");
    const int c = lane & 7;
#pragma unroll
    for (int j = 0; j < 4; ++j) { const int n = (lane >> 3) + 8 * j; const LAS float* s = scr + (8 * c) * 33 + n;
        v4u o; o.x = pk2(s[0 * 33], s[1 * 33]); o.y = pk2(s[2 * 33], s[3 * 33]); o.z = pk2(s[4 * 33], s[5 * 33]); o.w = pk2(s[6 * 33], s[7 * 33]);
        *(GAS v4u*)(x.WT + (size_t)n * x.dpitch + x.k0 + 8 * c) = o; }
    LDS_WAIT(); asm volatile("" ::: "memory");
}
struct InPtrs { const float* p[27]; };
constexpr int IT_DN = (FF / 64) * (D / 32), IT_IN = (D / 64) * (4096 / 32)  , IT_BA = (1024 / 64) * (D / 32), IT_BB = (512 / 64) * (D / 32),
              IT_DD = (D / 64) * (D / 32), IT_PP = (DPLE / 64) * (D / 32), IT_PL = 4 * 2 * 4;
constexpr int IT_LAYER = 2 * IT_DN + IT_IN + IT_BA + 2 * IT_BB + IT_DD + IT_PP + IT_PL;
__device__ __forceinline__ void xmat(XItem& x, int mode, const float* W, int N, const float* gv, bf16* WT, int dpitch, int dk, int item) {
    const int nblk = N / 32, kb = item / nblk, nbk = item - kb * nblk, n0 = 32 * nbk;
    const int drow = (mode == 0) ? n0 : (256 * (n0 >> 7) + 128 * (mode - 1) + (n0 & 127));
    x.W = W; x.gv = gv; x.WT = WT + (size_t)drow * dpitch + dk; x.ldw = N; x.dpitch = dpitch; x.k0 = 64 * kb; x.n0 = n0;
}
__device__ __forceinline__ void xdecode(XItem& x, const InPtrs& I, unsigned char* ws, int it) {
    const int l = it / IT_LAYER; int r = it - l * IT_LAYER;
    unsigned char* wl = ws + WS_W + (size_t)l * LAYER_W;
    if (r < IT_DN) { xmat(x, 0, I.p[5] + (size_t)l * FF * D, D, nullptr, (bf16*)(wl + OW_D1), FF, 0, r); return; } r -= IT_DN;
    if (r < IT_IN) { const int nblk = 4096 / 32, kb = r / nblk, nbk = r - kb * nblk;
        x.W = I.p[7] + (size_t)l * D * NIN; x.gv = I.p[6] + l * D; x.WT = (bf16*)(wl + OW_IN) + (size_t)(32 * nbk) * D; x.ldw = NIN; x.dpitch = D; x.k0 = 64 * kb; x.n0 = 32 * nbk; return; } r -= IT_IN;
    if (r < IT_BA) { xmat(x, 0, I.p[15] + (size_t)l * 1024 * D, D, nullptr, (bf16*)(wl + OW_BR), D, 0, r); return; } r -= IT_BA;
    if (r < IT_BB) { xmat(x, 0, I.p[16] + (size_t)l * 512 * D, D, nullptr, (bf16*)(wl + OW_BR), D, 1024, r); return; } r -= IT_BB;
    if (r < IT_BB) { xmat(x, 0, I.p[17] + (size_t)l * 512 * D, D, nullptr, (bf16*)(wl + OW_BR), D, 1536, r); return; } r -= IT_BB;
    if (r < IT_DD) { xmat(x, 0, I.p[18] + (size_t)l * D * D, D, nullptr, (bf16*)(wl + OW_OUT), D, 0, r); return; } r -= IT_DD;
    if (r < IT_DN) { xmat(x, 0, I.p[22] + (size_t)l * FF * D, D, nullptr, (bf16*)(wl + OW_D2), FF, 0, r); return; } r -= IT_DN;
    if (r < IT_PP) { xmat(x, 0, I.p[25] + (size_t)l * DPLE * D, D, nullptr, (bf16*)(wl + OW_P), D + DPLE, D, r); return; } r -= IT_PP;
    { const int g = r >> 3, rr = r & 7; xmat(x, 0, I.p[13] + ((size_t)l * 4 + g) * 128 * 128, 128, nullptr, (bf16*)(wl + OW_POOL) + (size_t)g * 128 * 128, 128, 0, rr); }
}
constexpr int SL_FF = FF / 32, SL_G = 6144 / 32, SL_P = D / 32, SL_LAYER = 4 * SL_FF + SL_G + SL_P;
struct Slab { const float* W; const float* gv; unsigned char* dst; float* sc; int ldw, dpitch, n0; };
__device__ __forceinline__ void slab_decode(Slab& b, const InPtrs& I, unsigned char* ws, int s) {
    const int l = s / SL_LAYER; int r = s - l * SL_LAYER;
    unsigned char* wl = ws + WS_W + (size_t)l * LAYER_W; float* const sc = (float*)(ws + WS_SC) + M;
    if (r < 4 * SL_FF) { const int f = r / (2 * SL_FF), up = (r / SL_FF) & 1, nb = r % SL_FF, n0 = 32 * nb, drow = 256 * (n0 >> 7) + 128 * up + (n0 & 127);
        b.W = I.p[f ? (up ? 21 : 20) : (up ? 4 : 3)] + (size_t)l * D * FF; b.gv = I.p[f ? 19 : 2] + l * D; b.ldw = FF; b.n0 = n0; b.dpitch = D * 2;
        b.dst = wl + (f ? OW_GU2 : OW_GU1) + (size_t)drow * (D * 2); b.sc = sc + DEPTH * (6144 + D) + (l * 2 + f) * (2 * FF) + drow; return; }
    r -= 4 * SL_FF;
    if (r < SL_G) { b.W = I.p[7] + (size_t)l * D * NIN; b.gv = I.p[6] + l * D; b.ldw = NIN; b.n0 = 4096 + 32 * r; b.dpitch = D * 2;
        b.dst = wl + OW_IN + (size_t)(4096 + 32 * r) * (D * 2); b.sc = sc + l * 6144 + 32 * r; return; }
    r -= SL_G;
    b.W = I.p[24] + (size_t)l * D * D; b.gv = I.p[23] + l * D; b.ldw = D; b.n0 = 32 * r; b.dpitch = (D + DPLE) * 2;
    b.dst = wl + OW_P + (size_t)(32 * r) * ((D + DPLE) * 2); b.sc = sc + DEPTH * 6144 + l * D + 32 * r;
}
__device__ __forceinline__ void slab_pass(Frame& F, const InPtrs& I, unsigned char* ws) {
    LAS bf16* slab = (LAS bf16*)(F.lds + RING_OFF);
    LAS float* cm = (LAS float*)(F.lds + MISC_OFF + 128);
    const int lane = F.lane, wave = F.wave, kr = lane >> 3, n4 = (lane & 7) * 4;
    for (int s = F.vcu; s < DEPTH * SL_LAYER; s += F.G) {
        Slab b; slab_decode(b, I, ws, s);
        float cmax[4] = {0.f, 0.f, 0.f, 0.f};
        f32x4 va[8], vb[8]; float ga[8], gb[8];
#define SLAB_LOAD(v, g, kb) do { _Pragma("unroll") for (int i = 0; i < 8; ++i) { const int k = 64 * (kb) + 8 * i + kr; v[i] = *(const GAS f32x4*)(b.W + (size_t)k * b.ldw + b.n0 + n4); g[i] = b.gv[k]; } } while (0)
#define SLAB_PUT(v, g, kb) do { _Pragma("unroll") for (int i = 0; i < 8; ++i) { const int k = 64 * (kb) + 8 * i + kr; const float x[4] = {v[i].x * g[i], v[i].y * g[i], v[i].z * g[i], v[i].w * g[i]}; \
            _Pragma("unroll") for (int j = 0; j < 4; ++j) { const unsigned hb = f2bf(x[j]); slab[(n4 + j) * 2048 + k] = (bf16)hb; cmax[j] = fmaxf(cmax[j], fabsf(bflo(hb))); } } } while (0)
        SLAB_LOAD(va, ga, wave);
        SLAB_LOAD(vb, gb, wave + 8);  SLAB_PUT(va, ga, wave);
        SLAB_LOAD(va, ga, wave + 16); SLAB_PUT(vb, gb, wave + 8);
        SLAB_LOAD(vb, gb, wave + 24); SLAB_PUT(va, ga, wave + 16);
        SLAB_PUT(vb, gb, wave + 24);
#undef SLAB_LOAD
#undef SLAB_PUT
#pragma unroll
        for (int j = 0; j < 4; ++j) { float c = cmax[j]; c = fmaxf(c, __shfl_xor(c, 8)); c = fmaxf(c, __shfl_xor(c, 16)); c = fmaxf(c, __shfl_xor(c, 32)); if (kr == 0) cm[wave * 32 + n4 + j] = c; }
        LDS_WAIT(); __syncthreads();
#pragma unroll
        for (int rr = 0; rr < 4; ++rr) { const int n = 4 * wave + rr; float amax = 0.f;
#pragma unroll
            for (int w = 0; w < 8; ++w) amax = fmaxf(amax, cm[w * 32 + n]);
            const float sq = amax > 0.f ? 127.0f / amax : 0.f; unsigned q[8];
#pragma unroll
            for (int j = 0; j < 4; ++j) { const v4u w4 = *(const LAS v4u*)(slab + n * 2048 + 32 * lane + 8 * j); float t[8]; t[0] = bflo(w4.x); t[1] = bfhi(w4.x); t[2] = bflo(w4.y); t[3] = bfhi(w4.y); t[4] = bflo(w4.z); t[5] = bfhi(w4.z); t[6] = bflo(w4.w); t[7] = bfhi(w4.w);
                q[2 * j] = ((unsigned)(int)rintf(t[0] * sq) & 0xffu) | (((unsigned)(int)rintf(t[1] * sq) & 0xffu) << 8) | (((unsigned)(int)rintf(t[2] * sq) & 0xffu) << 16) | (((unsigned)(int)rintf(t[3] * sq) & 0xffu) << 24);
                q[2 * j + 1] = ((unsigned)(int)rintf(t[4] * sq) & 0xffu) | (((unsigned)(int)rintf(t[5] * sq) & 0xffu) << 8) | (((unsigned)(int)rintf(t[6] * sq) & 0xffu) << 16) | (((unsigned)(int)rintf(t[7] * sq) & 0xffu) << 24); }
            unsigned char* drow = b.dst + (size_t)n * b.dpitch + 32 * lane;
            *(GAS v4u*)drow = (v4u){q[0], q[1], q[2], q[3]}; *(GAS v4u*)(drow + 16) = (v4u){q[4], q[5], q[6], q[7]};
            if (lane == 0) b.sc[n] = amax * (1.0f / 127.0f); }
        LDS_WAIT(); __syncthreads();
    }
}
__device__ __forceinline__ void xconvert_range(Frame& F, const InPtrs& I, unsigned char* ws, int it0, int NIT) {
    int tid_ = threadIdx.x; asm volatile("" : "+v"(tid_));
    const int lane = tid_ & 63, wave = __builtin_amdgcn_readfirstlane(tid_ >> 6);
    LAS float* scr = (LAS float*)(F.lds + RING_OFF + wave * 16384);
    const int gw = F.vcu * NWAVES + wave, NGW = F.G * NWAVES;
    XItem xa, xb; f32x4 va[8], vb[8]; float ga[8], gb[8];
    int it = it0 + gw;
    if (it < NIT) { xdecode(xa, I, ws, it); xitem_load(xa, lane, va, ga); }
    while (it < NIT) {
        const int it1 = it + NGW;
        if (it1 < NIT) { xdecode(xb, I, ws, it1); xitem_load(xb, lane, vb, gb); }
        xitem_store(xa, lane, va, ga, scr);
        const int it2 = it1 + NGW;
        if (it1 >= NIT) break;
        if (it2 < NIT) { xdecode(xa, I, ws, it2); xitem_load(xa, lane, va, ga); }
        xitem_store(xb, lane, vb, gb, scr);
        it = it2;
    }
}
__device__ __forceinline__ void p0_prologue(Frame& F, const InPtrs& I, unsigned char* ws, u64* ss0) {
    LAS float* scr = (LAS float*)(F.lds + RING_OFF + F.wave * 16384);
    const int gw = F.vcu * NWAVES + F.wave, NGW = F.G * NWAVES, lane = F.lane;
    slab_pass(F, I, ws);
    xconvert_range(F, I, ws, 0, DEPTH * IT_LAYER);
    const size_t gt = (size_t)F.vcu * (NWAVES * 64) + F.tid, GT = (size_t)F.G * NWAVES * 64;
    for (size_t i = gt; i < (size_t)DEPTH * 8 * 128 * 128 / 8; i += GT) {
        const size_t e0 = i * 8; const int l = (int)(e0 / (8 * 128 * 128)), rem = (int)(e0 % (8 * 128 * 128)), t = (rem / 128) % 128, s0 = rem % 128;
        const f32x4 a = *(const GAS f32x4*)(I.p[10] + e0), b = *(const GAS f32x4*)(I.p[10] + e0 + 4);
        v4u o; if ((s0 >> 6) <= (t >> 6)) { o.x = pk2(a.x, a.y); o.y = pk2(a.z, a.w); o.z = pk2(b.x, b.y); o.w = pk2(b.z, b.w); } else { o = (v4u){0u, 0u, 0u, 0u}; }
        *(GAS v4u*)((bf16*)(ws + WS_W + (size_t)l * LAYER_W + OW_SGU) + rem) = o; }
    for (size_t i = gt; i < (size_t)DEPTH * M * DPLE / 8; i += GT) {
        const size_t e0 = i * 8; const int l = (int)(e0 / ((size_t)M * DPLE)); const size_t rem = e0 % ((size_t)M * DPLE); const int m = (int)(rem / DPLE), j = (int)(rem % DPLE);
        const f32x4 a = *(const GAS f32x4*)(I.p[1] + e0), b = *(const GAS f32x4*)(I.p[1] + e0 + 4);
        v4u o; o.x = pk2(a.x, a.y); o.y = pk2(a.z, a.w); o.z = pk2(b.x, b.y); o.w = pk2(b.z, b.w);
        *(GAS v4u*)((bf16*)(ws + WS_PCAT) + (size_t)m * D + l * DPLE + j) = o; }
    for (int m = gw; m < M; m += NGW) {
        const float* xr = I.p[0] + (size_t)m * D; bf16* hr = (bf16*)(ws + WS_HB2) + (size_t)m * D; unsigned char* qr = ws + WS_HB8B + (size_t)m * D; float s = 0.f; f32x4 a[4], b[4];
#pragma unroll
        for (int j = 0; j < 4; ++j) { a[j] = *(const GAS f32x4*)(xr + 512 * j + 8 * lane); b[j] = *(const GAS f32x4*)(xr + 512 * j + 8 * lane + 4);
            s += (a[j].x * a[j].x + a[j].y * a[j].y) + (a[j].z * a[j].z + a[j].w * a[j].w) + (b[j].x * b[j].x + b[j].y * b[j].y) + (b[j].z * b[j].z + b[j].w * b[j].w); }
        s = wave_sum(s); const u64 sfix = (u64)(s * SS_SCALE + 0.5f); if (lane == 0) ss0[m] = sfix;
        const float qs = (127.0f / Q_SIGMAS) * __builtin_amdgcn_rsqf(fmaf((float)(unsigned)(sfix >> 32), 4294967296.0f, (float)(unsigned)sfix) * (SS_INV / (float)D) + EPS);
#pragma unroll
        for (int j = 0; j < 4; ++j) { v4u o; o.x = pkh2(a[j].x, a[j].y); o.y = pkh2(a[j].z, a[j].w); o.z = pkh2(b[j].x, b[j].y); o.w = pkh2(b[j].z, b[j].w); *(GAS v4u*)(hr + 512 * j + 8 * lane) = o;
            unsigned q0 = 0u, q1 = 0u; const float av[4] = {a[j].x, a[j].y, a[j].z, a[j].w}, bv[4] = {b[j].x, b[j].y, b[j].z, b[j].w};
#pragma unroll
            for (int e = 0; e < 4; ++e) { q0 |= ((unsigned)(int)fminf(fmaxf(rintf(av[e] * qs), -127.0f), 127.0f) & 0xffu) << (8 * e); q1 |= ((unsigned)(int)fminf(fmaxf(rintf(bv[e] * qs), -127.0f), 127.0f) & 0xffu) << (8 * e); }
            *(GAS v2u*)(qr + 512 * j + 8 * lane) = (v2u){q0, q1}; }
    }
}

struct SchedPlain {
    pg8::TileOrder T; const char* A; const char* B; size_t astep, bstep; int nt;
    __device__ __forceinline__ bool next(int i, pg8::Unit& u) const { int pm, pn; if (!T.tile(i, pm, pn)) return false; u.pm = pm; u.pn = pn; u.kind = 0; u.keep = 0; u.A = A + (size_t)pm * astep; u.B = B + (size_t)pn * bstep; u.nt = nt; return true; }
};
struct SchedBranch {
    pg8::TileOrder T; const char* A; const char* B; size_t astep, bstep;
    __device__ __forceinline__ bool next(int i, pg8::Unit& u) const { int pm, pn; const int ti = i / 3, sub = i - 3 * ti; if (!T.tile(ti, pm, pn)) return false; u.pm = pm; u.pn = pn; u.kind = sub; u.keep = (sub != 2);
        const size_t ko = sub == 0 ? 0 : (sub == 1 ? 2048 : 3072); u.A = A + (size_t)pm * astep + ko; u.B = B + (size_t)pn * bstep + ko; u.nt = sub == 0 ? 16 : 8; return true; }
};
struct SchedPle {
    pg8::TileOrder T; const char* Ap; const char* Ah; const char* B; size_t astep, bstep;
    __device__ __forceinline__ bool next(int i, pg8::Unit& u) const { int pm, pn; const int ti = i >> 1, sub = i & 1; if (!T.tile(ti, pm, pn)) return false; u.pm = pm; u.pn = pn; u.kind = sub; u.keep = 0;
        u.A = (sub == 0 ? Ap : Ah) + (size_t)pm * astep; u.B = B + (size_t)pn * bstep + (sub == 0 ? (size_t)D * 2 : 0); u.nt = sub == 0 ? DPLE / 64 : D / 64; return true; }
};

constexpr int GATE_BYTE0 = 4096 * 2;
typedef pg8::f32x4 A4;
__device__ __forceinline__ v4u pack8(const A4& a, const A4& b) { v4u w; w.x = pg8::cvt_pk_bf16(a[0], a[1]); w.y = pg8::cvt_pk_bf16(a[2], a[3]); w.z = pg8::cvt_pk_bf16(b[0], b[1]); w.w = pg8::cvt_pk_bf16(b[2], b[3]); return w; }
__device__ __forceinline__ v4u packh8(const A4& a, const A4& b) { v4u w; w.x = pkh2(a[0], a[1]); w.y = pkh2(a[2], a[3]); w.z = pkh2(b[0], b[1]); w.w = pkh2(b[2], b[3]); return w; }
__device__ __forceinline__ float dot2sq(const unsigned w, const float c) { const h16x2 h = __builtin_bit_cast(h16x2, w); return __builtin_amdgcn_fdot2(h, h, c, false); }
__device__ __forceinline__ float sumsqh8(const v4u w) { return dot2sq(w.w, dot2sq(w.z, dot2sq(w.y, dot2sq(w.x, 0.0f)))); }
__device__ __forceinline__ v2u ss_raw(const u64* ss, int row) { return *(const GAS v2u*)(ss + row); }
__device__ __forceinline__ float ss_cvt(const v2u w) { return fmaf((float)w.y, 4294967296.0f, (float)w.x) * (SS_INV / (float)D) + EPS; }
__device__ __forceinline__ float rinv_c(const v2u w) { return __builtin_amdgcn_rsqf(ss_cvt(w)); }
__device__ __forceinline__ float rms_c(const v2u w) { const float x = ss_cvt(w); return x * __builtin_amdgcn_rsqf(x); }
__device__ __forceinline__ float ssf(const u64* ss, int row) { const v2u w = *(const GAS v2u*)(ss + row); return fmaf((float)w.y, 4294967296.0f, (float)w.x); }
__device__ __forceinline__ float rinv_of(const u64* ss, int row) { return __builtin_amdgcn_rsqf(ssf(ss, row) * (SS_INV / (float)D) + EPS); }
__device__ __forceinline__ float rms_of(const u64* ss, int row) { const float x = ssf(ss, row) * (SS_INV / (float)D) + EPS; return x * __builtin_amdgcn_rsqf(x); }
__device__ __forceinline__ void ss_add(u64* ss, int row, float q) { (void)__hip_atomic_fetch_add((GAS u64*)(ss + row), (u64)(q * SS_SCALE + 0.5f), __ATOMIC_RELAXED, __HIP_MEMORY_SCOPE_AGENT); }

struct EpiSwiglu {
    bf16* hid; const u64* ss;
    __device__ __forceinline__ void operator()(A4 (&acc)[2][2][4][2], const pg8::Unit& u, int wr, int wc, int fr, int fq) const {
        const int row0 = u.pm * 256 + wr * 64 + fr, col0 = u.pn * 128 + wc * 32 + 8 * fq;
        v2u ra[2][4]; float rv[2][4];
#pragma unroll
        for (int ai = 0; ai < 2; ++ai)
#pragma unroll
            for (int m = 0; m < 4; ++m) ra[ai][m] = ss_raw(ss, row0 + ai * 128 + m * 16);
#pragma unroll
        for (int ai = 0; ai < 2; ++ai)
#pragma unroll
            for (int m = 0; m < 4; ++m) rv[ai][m] = rinv_c(ra[ai][m]);
#pragma unroll
        for (int ai = 0; ai < 2; ++ai)
#pragma unroll
            for (int m = 0; m < 4; ++m) { const int row = row0 + ai * 128 + m * 16; const float ri = rv[ai][m];
                A4 o[2];
#pragma unroll
                for (int n = 0; n < 2; ++n) { const A4 g = acc[ai][0][m][n] * ri, up = acc[ai][1][m][n] * ri;
#pragma unroll
                    for (int j = 0; j < 4; ++j) o[n][j] = g[j] * fast_sigmoid(g[j]) * up[j]; }
                *(GAS v4u*)(hid + (size_t)row * FFP + col0) = pack8(o[0], o[1]); }
    }
};
__device__ __forceinline__ float sumsq8(const v4u w) { const float a = bflo(w.x), b = bfhi(w.x), c = bflo(w.y), d = bfhi(w.y), e = bflo(w.z), f = bfhi(w.z), g = bflo(w.w), h = bfhi(w.w);
    return ((a * a + b * b) + (c * c + d * d)) + ((e * e + f * f) + (g * g + h * h)); }
__device__ __forceinline__ unsigned q8x4(const A4 v, float qs) {
    const float MAG = 12582912.0f;
    const f32x2 a = (f32x2){v[0], v[1]} * qs + MAG, b = (f32x2){v[2], v[3]} * qs + MAG;
    const unsigned x0 = __builtin_bit_cast(unsigned, __builtin_amdgcn_fmed3f(a.x, MAG - 127.0f, MAG + 127.0f)), x1 = __builtin_bit_cast(unsigned, __builtin_amdgcn_fmed3f(a.y, MAG - 127.0f, MAG + 127.0f));
    const unsigned x2 = __builtin_bit_cast(unsigned, __builtin_amdgcn_fmed3f(b.x, MAG - 127.0f, MAG + 127.0f)), x3 = __builtin_bit_cast(unsigned, __builtin_amdgcn_fmed3f(b.y, MAG - 127.0f, MAG + 127.0f));
    return __builtin_amdgcn_perm(__builtin_amdgcn_perm(x3, x2, 0x0c0c0400u), __builtin_amdgcn_perm(x1, x0, 0x0c0c0400u), 0x05040100u); }
struct EpiResid {
    const bf16* hin; bf16* hout; u64* ssout; unsigned char* h8; const u64* ssq; unsigned char* hbf; float scale;
    __device__ __forceinline__ void operator()(A4 (&acc)[2][2][4][2], const pg8::Unit& u, int wr, int wc, int fr, int fq) const {
        const int row0 = u.pm * 256 + wr * 64 + fr, col0 = u.pn * 256 + wc * 32 + 8 * fq;
        v4u o[4][2][2]; v2u rq[4][2];
#define RESID_LOAD(g) do { _Pragma("unroll") for (int mm = 0; mm < 2; ++mm) { const int row = row0 + ((g) >> 1) * 128 + (2 * ((g) & 1) + mm) * 16; \
            _Pragma("unroll") for (int bj = 0; bj < 2; ++bj) o[g][mm][bj] = *(const GAS v4u*)(hin + (size_t)row * D + col0 + bj * 128); \
            rq[g][mm] = h8 ? ss_raw(ssq, row) : (v2u){0u, 0u}; } } while (0)
#define RESID_COMP(g) do { _Pragma("unroll") for (int mm = 0; mm < 2; ++mm) { const int ai = (g) >> 1, m = 2 * ((g) & 1) + mm, row = row0 + ai * 128 + m * 16; float q = 0.f; const float qs = h8 ? rinv_c(rq[g][mm]) * (127.0f / Q_SIGMAS) : 0.f; \
            _Pragma("unroll") for (int bj = 0; bj < 2; ++bj) { const v4u ov = o[g][mm][bj]; const A4 a0 = acc[ai][bj][m][0], a1 = acc[ai][bj][m][1]; \
                const A4 v0 = {__builtin_fmaf(a0[0], scale, hlo(ov.x)), __builtin_fmaf(a0[1], scale, hhi(ov.x)), __builtin_fmaf(a0[2], scale, hlo(ov.y)), __builtin_fmaf(a0[3], scale, hhi(ov.y))}; \
                const A4 v1 = {__builtin_fmaf(a1[0], scale, hlo(ov.z)), __builtin_fmaf(a1[1], scale, hhi(ov.z)), __builtin_fmaf(a1[2], scale, hlo(ov.w)), __builtin_fmaf(a1[3], scale, hhi(ov.w))}; \
                const v4u w = packh8(v0, v1); *(GAS v4u*)(hout + (size_t)row * D + col0 + bj * 128) = w; q += sumsqh8(w); \
                if (h8) *(GAS v2u*)(h8 + (size_t)row * D + col0 + bj * 128) = (v2u){q8x4(v0, qs), q8x4(v1, qs)}; \
                if (hbf) *(GAS v4u*)(hbf + ((size_t)row * D + col0 + bj * 128) * 2) = pack8(v0, v1); } \
            q += __shfl_xor(q, 16); q += __shfl_xor(q, 32); \
            if (fq == 0) ss_add(ssout, row, q); } } while (0)
        RESID_LOAD(0); RESID_LOAD(1); RESID_COMP(0); RESID_LOAD(2); RESID_COMP(1); RESID_LOAD(3); RESID_COMP(2); RESID_COMP(3);
#undef RESID_LOAD
#undef RESID_COMP
    }
};
struct EpiWin {
    bf16* z; const u64* ss; int pn0;
    __device__ __forceinline__ void operator()(A4 (&acc)[2][2][4][2], const pg8::Unit& u, int wr, int wc, int fr, int fq) const {
        const int pnz = u.pn + pn0; const int row0 = u.pm * 256 + wr * 64 + fr, col0 = pnz * 256 + wc * 32 + 8 * fq; const int act = pnz < 8 ? 1 : 0;
        v2u ra[2][4]; float rv[2][4];
#pragma unroll
        for (int ai = 0; ai < 2; ++ai)
#pragma unroll
            for (int m = 0; m < 4; ++m) ra[ai][m] = ss_raw(ss, row0 + ai * 128 + m * 16);
#pragma unroll
        for (int ai = 0; ai < 2; ++ai)
#pragma unroll
            for (int m = 0; m < 4; ++m) rv[ai][m] = rinv_c(ra[ai][m]);
        if (act == 1) {
#pragma unroll
            for (int ai = 0; ai < 2; ++ai)
#pragma unroll
                for (int m = 0; m < 4; ++m) { const int row = row0 + ai * 128 + m * 16; const float ri = rv[ai][m];
#pragma unroll
                    for (int bj = 0; bj < 2; ++bj) { const A4 v0 = acc[ai][bj][m][0] * ri, v1 = acc[ai][bj][m][1] * ri;
                        f32x2 g[4] = {{v0[0], v0[1]}, {v0[2], v0[3]}, {v1[0], v1[1]}, {v1[2], v1[3]}}; pg8::gelu_pk4(g);
                        *(GAS v4u*)(z + (size_t)row * ZP + col0 + bj * 128) = pack8((A4){g[0].x, g[0].y, g[1].x, g[1].y}, (A4){g[2].x, g[2].y, g[3].x, g[3].y}); } }
        } else {
#pragma unroll
            for (int ai = 0; ai < 2; ++ai)
#pragma unroll
                for (int m = 0; m < 4; ++m) { const int row = row0 + ai * 128 + m * 16; const float ri = rv[ai][m];
#pragma unroll
                    for (int bj = 0; bj < 2; ++bj) *(GAS v4u*)(z + (size_t)row * ZP + col0 + bj * 128) = pack8(acc[ai][bj][m][0] * ri, acc[ai][bj][m][1] * ri); }
        }
    }
};
typedef pg8::i32x4 I4;
struct EpiGate8 {
    bf16* z; const u64* ss; const float* ascale; const float* wscale;
    __device__ __forceinline__ void operator()(I4 (&acc)[2][2][4][2], const pg8::Unit& u, int wr, int wc, int fr, int fq) const {
        const int row0 = u.pm * 256 + wr * 64 + fr, col0 = u.pn * 256 + wc * 32 + 8 * fq;
        f32x4 wraw[2][2];
#pragma unroll
        for (int bj = 0; bj < 2; ++bj) { wraw[bj][0] = *(const GAS f32x4*)(wscale + col0 + bj * 128); wraw[bj][1] = *(const GAS f32x4*)(wscale + col0 + bj * 128 + 4); }
        v2u ra[2][4]; float as[2][4], rv[2][4];
#pragma unroll
        for (int ai = 0; ai < 2; ++ai)
#pragma unroll
            for (int m = 0; m < 4; ++m) { const int row = row0 + ai * 128 + m * 16; ra[ai][m] = ss_raw(ss, row); as[ai][m] = ascale[row]; }
#pragma unroll
        for (int ai = 0; ai < 2; ++ai)
#pragma unroll
            for (int m = 0; m < 4; ++m) rv[ai][m] = rinv_c(ra[ai][m]) * as[ai][m];
#pragma unroll
        for (int bj = 0; bj < 2; ++bj) { const f32x4 w0 = wraw[bj][0] * -1.44269504089f, w1 = wraw[bj][1] * -1.44269504089f;
            const f32x2 wn[4] = {{w0[0], w0[1]}, {w0[2], w0[3]}, {w1[0], w1[1]}, {w1[2], w1[3]}};
#pragma unroll
            for (int ai = 0; ai < 2; ++ai)
#pragma unroll
                for (int m = 0; m < 4; ++m) { const int row = row0 + ai * 128 + m * 16; const float ri = rv[ai][m]; unsigned x[8];
                    f32x2 t2[4], d2[4], r2[4], w2[4];
#pragma unroll
                    for (int p = 0; p < 4; ++p) { const I4 av = acc[ai][bj][m][p >> 1]; const int j = 2 * (p & 1); const f32x2 a2 = {(float)av[j], (float)av[j + 1]}; t2[p] = a2 * (wn[p] * ri); }
#pragma unroll
                    for (int p = 0; p < 4; ++p) d2[p] = (f32x2){__builtin_amdgcn_exp2f(t2[p].x), __builtin_amdgcn_exp2f(t2[p].y)} + 1.0f;
#pragma unroll
                    for (int p = 0; p < 4; ++p) r2[p] = (f32x2){__builtin_amdgcn_rcpf(d2[p].x), __builtin_amdgcn_rcpf(d2[p].y)};
#pragma unroll
                    for (int p = 0; p < 4; ++p) w2[p] = r2[p] * 255.0f + 8388608.0f;
#pragma unroll
                    for (int p = 0; p < 4; ++p) { x[2 * p] = __builtin_bit_cast(unsigned, fmaxf(w2[p].x, 8388609.0f)); x[2 * p + 1] = __builtin_bit_cast(unsigned, fmaxf(w2[p].y, 8388609.0f)); }
                    const unsigned q0 = __builtin_amdgcn_perm(__builtin_amdgcn_perm(x[3], x[2], 0x0c0c0400u), __builtin_amdgcn_perm(x[1], x[0], 0x0c0c0400u), 0x05040100u);
                    const unsigned q1 = __builtin_amdgcn_perm(__builtin_amdgcn_perm(x[7], x[6], 0x0c0c0400u), __builtin_amdgcn_perm(x[5], x[4], 0x0c0c0400u), 0x05040100u);
                    *(GAS v2u*)((unsigned char*)z + (size_t)row * (ZP * 2) + GATE_BYTE0 + col0 + bj * 128) = (v2u){q0, q1}; } }
    }
};
__device__ __forceinline__ void u8x8_to_f(const v2u w, float (&f)[8]) {
    f[0] = (float)(w.x & 0xffu); f[1] = (float)((w.x >> 8) & 0xffu); f[2] = (float)((w.x >> 16) & 0xffu); f[3] = (float)(w.x >> 24);
    f[4] = (float)(w.y & 0xffu); f[5] = (float)((w.y >> 8) & 0xffu); f[6] = (float)((w.y >> 16) & 0xffu); f[7] = (float)(w.y >> 24); }
struct EpiBranch {
    const bf16* z; bf16* mb;
    __device__ __forceinline__ void operator()(A4 (&acc)[2][2][4][2], const pg8::Unit& u, int wr, int wc, int fr, int fq) const {
        const int row0 = u.pm * 256 + wr * 64 + fr, col0 = u.pn * 256 + wc * 32 + 8 * fq; const int kind = u.kind;
        const unsigned char* gbase = (const unsigned char*)z + GATE_BYTE0 + col0;
        v2u ga[4][2][2], gb[4][2][2];
#define BR_LOAD(g) do { _Pragma("unroll") for (int mm = 0; mm < 2; ++mm) _Pragma("unroll") for (int bj = 0; bj < 2; ++bj) { \
            const unsigned char* gp = gbase + (size_t)(row0 + ((g) >> 1) * 128 + (2 * ((g) & 1) + mm) * 16) * (ZP * 2) + bj * 128; \
            ga[g][mm][bj] = *(const GAS v2u*)(gp + kind * 2048); gb[g][mm][bj] = (kind != 2) ? *(const GAS v2u*)(gp + (kind + 1) * 2048) : (v2u){0u, 0u}; } } while (0)
#define BR_COMP(g) do { _Pragma("unroll") for (int mm = 0; mm < 2; ++mm) _Pragma("unroll") for (int bj = 0; bj < 2; ++bj) { const int ai = (g) >> 1, m = 2 * ((g) & 1) + mm; float a[8], b[8]; u8x8_to_f(ga[g][mm][bj], a); \
            if (kind != 2) { u8x8_to_f(gb[g][mm][bj], b); _Pragma("unroll") for (int j = 0; j < 8; ++j) a[j] *= __builtin_amdgcn_rcpf(b[j]); } \
            else { _Pragma("unroll") for (int j = 0; j < 8; ++j) a[j] *= (1.0f / 255.0f); } \
            acc[ai][bj][m][0] *= (A4){a[0], a[1], a[2], a[3]}; acc[ai][bj][m][1] *= (A4){a[4], a[5], a[6], a[7]}; \
            if (kind == 2) *(GAS v4u*)(mb + (size_t)(row0 + ai * 128 + m * 16) * D + col0 + bj * 128) = pack8(acc[ai][bj][m][0], acc[ai][bj][m][1]); } } while (0)
        BR_LOAD(0); BR_LOAD(1); BR_COMP(0); BR_LOAD(2); BR_COMP(1); BR_LOAD(3); BR_COMP(2); BR_COMP(3);
#undef BR_LOAD
#undef BR_COMP
    }
};
struct EpiPle {
    const bf16* hin; bf16* hout; bf16* tmp; const u64* ss; u64* ssout;
    __device__ __forceinline__ void operator()(A4 (&acc)[2][2][4][2], const pg8::Unit& u, int wr, int wc, int fr, int fq) const {
        const int row0 = u.pm * 256 + wr * 64 + fr, col0 = u.pn * 256 + wc * 32 + 8 * fq; const int kind = u.kind;
        if (kind == 0) {
#pragma unroll
            for (int ai = 0; ai < 2; ++ai)
#pragma unroll
                for (int m = 0; m < 4; ++m)
#pragma unroll
                    for (int bj = 0; bj < 2; ++bj) *(GAS v4u*)(tmp + (size_t)(row0 + ai * 128 + m * 16) * D + col0 + bj * 128) = pack8(acc[ai][bj][m][0], acc[ai][bj][m][1]);
        } else {
#pragma unroll
            for (int ai = 0; ai < 2; ++ai)
#pragma unroll
            for (int mh = 0; mh < 2; ++mh) {
                v4u o[2][2], t[2][2]; float ri[2];
#pragma unroll
                for (int mm = 0; mm < 2; ++mm) { const int row = row0 + ai * 128 + (2 * mh + mm) * 16; ri[mm] = rinv_of(ss, row);
#pragma unroll
                    for (int bj = 0; bj < 2; ++bj) { const size_t off = (size_t)row * D + col0 + bj * 128; o[mm][bj] = *(const GAS v4u*)(hin + off); t[mm][bj] = *(const GAS v4u*)(tmp + off); } }
#pragma unroll
                for (int mm = 0; mm < 2; ++mm) { const int m = 2 * mh + mm, row = row0 + ai * 128 + m * 16; float q = 0.f;
#pragma unroll
                    for (int bj = 0; bj < 2; ++bj) { const v4u ov = o[mm][bj], tv = t[mm][bj];
                        A4 g0 = acc[ai][bj][m][0] * ri[mm], g1 = acc[ai][bj][m][1] * ri[mm];
#pragma unroll
                        for (int j = 0; j < 4; ++j) { g0[j] = fast_sigmoid(g0[j]); g1[j] = fast_sigmoid(g1[j]); }
                        const A4 v0 = (A4){bflo(ov.x), bfhi(ov.x), bflo(ov.y), bfhi(ov.y)} + g0 * (A4){bflo(tv.x), bfhi(tv.x), bflo(tv.y), bfhi(tv.y)}, v1 = (A4){bflo(ov.z), bfhi(ov.z), bflo(ov.w), bfhi(ov.w)} + g1 * (A4){bflo(tv.z), bfhi(tv.z), bflo(tv.w), bfhi(tv.w)};
                        const v4u w = pack8(v0, v1); *(GAS v4u*)(hout + (size_t)row * D + col0 + bj * 128) = w; q += sumsq8(w); }
                    q += __shfl_xor(q, 16); q += __shfl_xor(q, 32);
                    if (fq == 0) ss_add(ssout, row, q); }
            }
        }
    }
};

struct EpiSwiglu8 {
    bf16* hid; const u64* ss; const u64* ssq; const float* wscale;
    __device__ __forceinline__ void operator()(I4 (&acc)[2][2][4][2], const pg8::Unit& u, int wr, int wc, int fr, int fq) const {
        const int row0 = u.pm * 256 + wr * 64 + fr, col0 = u.pn * 128 + wc * 32 + 8 * fq, wrow0 = u.pn * 256 + wc * 32 + 8 * fq;
        bf16* const hblk = hid + ((size_t)(u.pm * (FF / 64) + u.pn * 2 + (wc >> 1)) * 256 + wr * 64 + fr) * 64 + (wc & 1) * 32 + 8 * fq;
        const f32x4 g0w = *(const GAS f32x4*)(wscale + wrow0), g1w = *(const GAS f32x4*)(wscale + wrow0 + 4), u0w = *(const GAS f32x4*)(wscale + wrow0 + 128), u1w = *(const GAS f32x4*)(wscale + wrow0 + 132);
        v2u ra[2][4], rb[2][4]; float rv[2][4];
#pragma unroll
        for (int ai = 0; ai < 2; ++ai)
#pragma unroll
            for (int m = 0; m < 4; ++m) { const int row = row0 + ai * 128 + m * 16; ra[ai][m] = ss_raw(ss, row); rb[ai][m] = ss_raw(ssq, row); }
#pragma unroll
        for (int ai = 0; ai < 2; ++ai)
#pragma unroll
            for (int m = 0; m < 4; ++m) rv[ai][m] = rinv_c(ra[ai][m]) * (Q_SIGMAS / 127.0f) * rms_c(rb[ai][m]);
        f32x2 gn[4], gu[4];
#pragma unroll
        for (int q = 0; q < 2; ++q) { const f32x4 gw = q ? g1w : g0w, uw = q ? u1w : u0w;
            gn[2 * q] = (f32x2){gw[0], gw[1]} * -1.44269504089f; gn[2 * q + 1] = (f32x2){gw[2], gw[3]} * -1.44269504089f;
            gu[2 * q] = (f32x2){gw[0], gw[1]} * (f32x2){uw[0], uw[1]}; gu[2 * q + 1] = (f32x2){gw[2], gw[3]} * (f32x2){uw[2], uw[3]}; }
#pragma unroll
        for (int ai = 0; ai < 2; ++ai)
#pragma unroll
            for (int m = 0; m < 4; ++m) { const float ri = rv[ai][m], ri2 = ri * ri; f32x2 o[4];
#pragma unroll
                for (int p = 0; p < 4; ++p) { const I4 ag = acc[ai][0][m][p >> 1], au = acc[ai][1][m][p >> 1]; const int j = 2 * (p & 1);
                    const f32x2 a2 = {(float)ag[j], (float)ag[j + 1]}, b2 = {(float)au[j], (float)au[j + 1]};
                    const f32x2 t2 = a2 * (gn[p] * ri);
                    const f32x2 d2 = (f32x2){__builtin_amdgcn_exp2f(t2.x), __builtin_amdgcn_exp2f(t2.y)} + 1.0f;
                    const f32x2 r2 = {__builtin_amdgcn_rcpf(d2.x), __builtin_amdgcn_rcpf(d2.y)};
                    o[p] = ((a2 * b2) * (gu[p] * ri2)) * r2; }
                v4u w; w.x = pg8::cvt_pk_bf16(o[0].x, o[0].y); w.y = pg8::cvt_pk_bf16(o[1].x, o[1].y); w.z = pg8::cvt_pk_bf16(o[2].x, o[2].y); w.w = pg8::cvt_pk_bf16(o[3].x, o[3].y);
                *(GAS v4u*)(hblk + (size_t)(ai * 128 + m * 16) * 64) = w; }
    }
};
struct EpiProj {
    bf16* tmp;
    __device__ __forceinline__ void operator()(A4 (&acc)[2][2][4][2], const pg8::Unit& u, int wr, int wc, int fr, int fq) const {
        const int row0 = u.pm * 256 + wr * 64 + fr, col0 = u.pn * 256 + wc * 32 + 8 * fq;
#pragma unroll
        for (int ai = 0; ai < 2; ++ai)
#pragma unroll
            for (int m = 0; m < 4; ++m)
#pragma unroll
                for (int bj = 0; bj < 2; ++bj) *(GAS v4u*)(tmp + (size_t)(row0 + ai * 128 + m * 16) * D + col0 + bj * 128) = pack8(acc[ai][bj][m][0], acc[ai][bj][m][1]);
    }
};
struct EpiPleGate8 {
    const bf16* hin; bf16* hout; const bf16* tmp; const u64* ss; const u64* ssq; const float* wscale; u64* ssout; unsigned char* h8;
    __device__ __forceinline__ void operator()(I4 (&acc)[2][2][4][2], const pg8::Unit& u, int wr, int wc, int fr, int fq) const {
        const int row0 = u.pm * 256 + wr * 64 + fr, col0 = u.pn * 256 + wc * 32 + 8 * fq;
#pragma unroll
        for (int ai = 0; ai < 2; ++ai) {
            v2u ra[4], rb[4]; float rv[4], qq[4], qsv[4];
#pragma unroll
            for (int m = 0; m < 4; ++m) { const int row = row0 + ai * 128 + m * 16; ra[m] = ss_raw(ss, row); rb[m] = ss_raw(ssq, row); }
#pragma unroll
            for (int m = 0; m < 4; ++m) { const float r3 = rinv_c(ra[m]); rv[m] = r3 * (Q_SIGMAS / 127.0f) * rms_c(rb[m]); qq[m] = 0.f; qsv[m] = r3 * (127.0f / Q_SIGMAS); }
#pragma unroll
            for (int bj = 0; bj < 2; ++bj) { const f32x4 w0 = *(const GAS f32x4*)(wscale + col0 + bj * 128), w1 = *(const GAS f32x4*)(wscale + col0 + bj * 128 + 4);
                v4u o[4], t[4];
#pragma unroll
                for (int m = 0; m < 4; ++m) { const size_t off = (size_t)(row0 + ai * 128 + m * 16) * D + col0 + bj * 128; o[m] = *(const GAS v4u*)(hin + off); t[m] = *(const GAS v4u*)(tmp + off); }
#pragma unroll
                for (int m = 0; m < 4; ++m) { const int row = row0 + ai * 128 + m * 16; const float ri = rv[m]; const v4u ov = o[m], tv = t[m]; A4 g0, g1;
#pragma unroll
                    for (int j = 0; j < 4; ++j) { g0[j] = fast_sigmoid((float)acc[ai][bj][m][0][j] * ri * w0[j]); g1[j] = fast_sigmoid((float)acc[ai][bj][m][1][j] * ri * w1[j]); }
                    const A4 v0 = (A4){hlo(ov.x), hhi(ov.x), hlo(ov.y), hhi(ov.y)} + g0 * (A4){bflo(tv.x), bfhi(tv.x), bflo(tv.y), bfhi(tv.y)}, v1 = (A4){hlo(ov.z), hhi(ov.z), hlo(ov.w), hhi(ov.w)} + g1 * (A4){bflo(tv.z), bfhi(tv.z), bflo(tv.w), bfhi(tv.w)};
                    const v4u w = packh8(v0, v1); *(GAS v4u*)(hout + (size_t)row * D + col0 + bj * 128) = w; qq[m] += sumsqh8(w);
                    *(GAS v2u*)(h8 + (size_t)row * D + col0 + bj * 128) = (v2u){q8x4(v0, qsv[m]), q8x4(v1, qsv[m])}; } }
#pragma unroll
            for (int m = 0; m < 4; ++m) { float q = qq[m]; q += __shfl_xor(q, 16); q += __shfl_xor(q, 32); if (fq == 0) ss_add(ssout, row0 + ai * 128 + m * 16, q); }
        }
    }
};
constexpr int TP = 136;
__device__ __forceinline__ void unpack8(const v4u w, float (&f)[8]) { f[0] = bflo(w.x); f[1] = bfhi(w.x); f[2] = bflo(w.y); f[3] = bfhi(w.y); f[4] = bflo(w.z); f[5] = bfhi(w.z); f[6] = bflo(w.w); f[7] = bfhi(w.w); }
template <bool SRC_F16>
__device__ __forceinline__ void quant_row(const bf16* srow, unsigned char* drow, float* sc, int lane) {
    v4u w[4]; float f[32];
#pragma unroll
    for (int j = 0; j < 4; ++j) w[j] = *(const GAS v4u*)(srow + 32 * lane + 8 * j);
    float amax = 0.f;
#pragma unroll
    for (int j = 0; j < 4; ++j) { float t[8];
        if (SRC_F16) { t[0] = hlo(w[j].x); t[1] = hhi(w[j].x); t[2] = hlo(w[j].y); t[3] = hhi(w[j].y); t[4] = hlo(w[j].z); t[5] = hhi(w[j].z); t[6] = hlo(w[j].w); t[7] = hhi(w[j].w); } else unpack8(w[j], t);
#pragma unroll
        for (int e = 0; e < 8; ++e) { f[8 * j + e] = t[e]; amax = fmaxf(amax, fabsf(t[e])); } }
#pragma unroll
    for (int o = 1; o < 64; o <<= 1) amax = fmaxf(amax, __shfl_xor(amax, o));
    const float s = amax > 0.f ? 127.0f / amax : 0.f;
    v4u o0, o1; unsigned q[8];
#pragma unroll
    for (int j = 0; j < 8; ++j) { const int a = (int)rintf(f[4 * j] * s), b = (int)rintf(f[4 * j + 1] * s), c = (int)rintf(f[4 * j + 2] * s), d = (int)rintf(f[4 * j + 3] * s);
        q[j] = ((unsigned)a & 0xffu) | (((unsigned)b & 0xffu) << 8) | (((unsigned)c & 0xffu) << 16) | (((unsigned)d & 0xffu) << 24); }
    o0 = (v4u){q[0], q[1], q[2], q[3]}; o1 = (v4u){q[4], q[5], q[6], q[7]};
    *(GAS v4u*)(drow + 32 * lane) = o0; *(GAS v4u*)(drow + 32 * lane + 16) = o1;
    if (lane == 0) *sc = amax * (1.0f / 127.0f);
}
__device__ __forceinline__ void quant_h_phase(Frame& F, const bf16* __restrict__ h, unsigned char* __restrict__ h8, float* __restrict__ ascale) {
    int tid_ = threadIdx.x; asm volatile("" : "+v"(tid_));
    const int lane = tid_ & 63, wave = __builtin_amdgcn_readfirstlane(tid_ >> 6);
    if (F.G == 256) { const int base = (F.vcu >> 5) * 2048 + (F.vcu & 31) * NWAVES + wave;
        for (int jj = 0; jj < 8; ++jj) { const int m = base + 256 * jj; quant_row<true>(h + (size_t)m * D, h8 + (size_t)m * D, ascale + m, lane); }
    } else { const int gw = F.vcu * NWAVES + wave, NGW = F.G * NWAVES; for (int m = gw; m < M; m += NGW) quant_row<true>(h + (size_t)m * D, h8 + (size_t)m * D, ascale + m, lane); }
}
__device__ __forceinline__ void mixer_phase(Frame& F, const bf16* __restrict__ z, bf16* __restrict__ ycat, const float* __restrict__ ng, const float* __restrict__ nbias, const bf16* __restrict__ sguw,
                                            const float* __restrict__ sgub, const float* __restrict__ convw, const bf16* __restrict__ poolwt, const float* __restrict__ pscale) {
    LAS f32x2* stats = (LAS f32x2*)(F.lds + RING_OFF);
    LAS bf16* tile0 = (LAS bf16*)(F.lds + RING_OFF + 1024);
    constexpr int TILE_ELEMS = 128 * TP + 64;
    int tid_ = threadIdx.x; asm volatile("" : "+v"(tid_));
    const int tid = tid_, lane = tid & 63, wave = __builtin_amdgcn_readfirstlane(tid >> 6), fr = lane & 15, fq = lane >> 4;
    for (int un = F.vcu; un < 2 * (M / 128); un += F.G) {
        const int nbk = un >> 1, half = un & 1, row0 = nbk * 128;
        for (int tb = 0; tb < 4; ++tb) { v4u ra[4], rb[4];
#pragma unroll
            for (int tt = 0; tt < 4; ++tt) { const bf16* vp = z + (size_t)(row0 + 16 * wave + 4 * tb + tt) * ZP + 1024 + 16 * lane; ra[tt] = *(const GAS v4u*)vp; rb[tt] = *(const GAS v4u*)(vp + 8); }
#pragma unroll
            for (int tt = 0; tt < 4; ++tt) { float f[16];
                { float g[8]; unpack8(ra[tt], g);
#pragma unroll
                  for (int j = 0; j < 8; ++j) f[j] = g[j];
                  unpack8(rb[tt], g);
#pragma unroll
                  for (int j = 0; j < 8; ++j) f[8 + j] = g[j]; }
                float s = 0.f;
#pragma unroll
                for (int j = 0; j < 16; ++j) s += f[j];
                const float mean = wave_sum(s) * (1.0f / 1024.0f); float q = 0.f;
#pragma unroll
                for (int j = 0; j < 16; ++j) { const float d = f[j] - mean; q += d * d; }
                const float rstd = 1.0f / sqrtf(wave_sum(q) * (1.0f / 1024.0f) + EPS);
                if (lane == 0) stats[16 * wave + 4 * tb + tt] = (f32x2){mean, rstd}; } }
        const int srow = tid >> 2, cq = tid & 3;
        v4u raw[4];
#pragma unroll
        for (int q = 0; q < 4; ++q) raw[q] = *(const GAS v4u*)(z + (size_t)(row0 + srow) * ZP + 1024 + (half * 4) * 128 + 8 * cq + 32 * q);
        LDS_WAIT(); __syncthreads();
        const f32x2 st = stats[srow];
        for (int gi = 0; gi < 4; ++gi) { const int g = half * 4 + gi; LAS bf16* tile = tile0 + (gi & 1) * TILE_ELEMS;
            f32x4 lg[4][2], lb[4][2];
#pragma unroll
            for (int q = 0; q < 4; ++q) { const int ch = g * 128 + 8 * cq + 32 * q; lg[q][0] = *(const GAS f32x4*)(ng + ch); lg[q][1] = *(const GAS f32x4*)(ng + ch + 4); lb[q][0] = *(const GAS f32x4*)(nbias + ch); lb[q][1] = *(const GAS f32x4*)(nbias + ch + 4); }
#pragma unroll
            for (int q = 0; q < 4; ++q) { const int c8 = 8 * cq + 32 * q; float f[8]; unpack8(raw[q], f);
                const f32x4 g0 = lg[q][0], g1 = lg[q][1], b0 = lb[q][0], b1 = lb[q][1];
                const float gg[8] = {g0.x, g0.y, g0.z, g0.w, g1.x, g1.y, g1.z, g1.w}, bb[8] = {b0.x, b0.y, b0.z, b0.w, b1.x, b1.y, b1.z, b1.w};
#pragma unroll
                for (int e = 0; e < 8; ++e) tile[(c8 + e) * TP + srow] = (bf16)f2bf((f[e] - st.x) * st.y * gg[e] + bb[e]); }
            if (gi < 3) {
#pragma unroll
                for (int q = 0; q < 4; ++q) raw[q] = *(const GAS v4u*)(z + (size_t)(row0 + srow) * ZP + 1024 + (g + 1) * 128 + 8 * cq + 32 * q); }
            const int t = 16 * wave + fr, row = row0 + t; const float bias = sgub[g * 128 + t];
            v2u uw[8];
#pragma unroll
            for (int ct = 0; ct < 8; ++ct) uw[ct] = *(const GAS v2u*)(z + (size_t)row * ZP + g * 128 + ct * 16 + 4 * fq);
            bf16x8 wf[4];
#pragma unroll
            for (int kk = 0; kk < 4; ++kk) wf[kk] = *(const GAS bf16x8*)(sguw + ((size_t)g * 128 + 16 * wave + fr) * 128 + kk * 32 + 8 * fq);
            LDS_WAIT(); __syncthreads();
            A4 acc[8];
#pragma unroll
            for (int ct = 0; ct < 8; ++ct) acc[ct] = (A4){0.f, 0.f, 0.f, 0.f};
#pragma unroll
            for (int kk = 0; kk < 4; ++kk) { if (kk < 2 || wave >= 4) {
#pragma unroll
                for (int ct = 0; ct < 8; ++ct) { const bf16x8 vf = *(const LAS bf16x8*)(tile + (ct * 16 + fr) * TP + kk * 32 + 8 * fq);
                    acc[ct] = __builtin_amdgcn_mfma_f32_16x16x32_bf16(vf, wf[kk], acc[ct], 0, 0, 0); } } }
#pragma unroll
            for (int ct = 0; ct < 8; ++ct) { const int col = g * 128 + ct * 16 + 4 * fq;
                v2u o; o.x = pk2(bflo(uw[ct].x) * (acc[ct][0] + bias), bfhi(uw[ct].x) * (acc[ct][1] + bias)); o.y = pk2(bflo(uw[ct].y) * (acc[ct][2] + bias), bfhi(uw[ct].y) * (acc[ct][3] + bias));
                *(GAS v2u*)(ycat + (size_t)row * D + col) = o; }
        }
        LDS_WAIT(); __syncthreads();
        if (half == 0) {
            const int c8 = 8 * lane; float cw[3][8];
#pragma unroll
            for (int k = 0; k < 3; ++k) { const f32x4 a = *(const GAS f32x4*)(convw + k * 512 + c8), b = *(const GAS f32x4*)(convw + k * 512 + c8 + 4);
                cw[k][0] = a.x; cw[k][1] = a.y; cw[k][2] = a.z; cw[k][3] = a.w; cw[k][4] = b.x; cw[k][5] = b.y; cw[k][6] = b.z; cw[k][7] = b.w; }
            float y2[8], y1[8];
            { const int r0 = row0 + 16 * wave, ts = r0 % SEQ;
#pragma unroll
              for (int e = 0; e < 8; ++e) { y2[e] = 0.f; y1[e] = 0.f; }
              if (ts >= 2) { const bf16* zr2 = z + (size_t)(r0 - 2) * ZP + 2048; const bf16* zr1 = zr2 + ZP; float c[8], x[8];
                  const v4u c2 = *(const GAS v4u*)(zr2 + 512 + c8), x2 = *(const GAS v4u*)(zr2 + 1024 + c8), c1 = *(const GAS v4u*)(zr1 + 512 + c8), x1 = *(const GAS v4u*)(zr1 + 1024 + c8);
                  unpack8(c2, c); unpack8(x2, x);
#pragma unroll
                  for (int e = 0; e < 8; ++e) y2[e] = c[e] * x[e];
                  unpack8(c1, c); unpack8(x1, x);
#pragma unroll
                  for (int e = 0; e < 8; ++e) y1[e] = c[e] * x[e]; } }
            for (int tb = 0; tb < 4; ++tb) { v4u rb[4], rc[4], rx[4];
#pragma unroll
                for (int tt = 0; tt < 4; ++tt) { const bf16* zr = z + (size_t)(row0 + 16 * wave + 4 * tb + tt) * ZP + 2048; rb[tt] = *(const GAS v4u*)(zr + c8); rc[tt] = *(const GAS v4u*)(zr + 512 + c8); rx[tt] = *(const GAS v4u*)(zr + 1024 + c8); }
#pragma unroll
                for (int tt = 0; tt < 4; ++tt) { const int row = row0 + 16 * wave + 4 * tb + tt; float b[8], c[8], x[8], o[8]; unpack8(rb[tt], b); unpack8(rc[tt], c); unpack8(rx[tt], x);
#pragma unroll
                    for (int e = 0; e < 8; ++e) { const float y0 = c[e] * x[e]; o[e] = b[e] * (cw[0][e] * y2[e] + cw[1][e] * y1[e] + cw[2][e] * y0); y2[e] = y1[e]; y1[e] = y0; }
                    v4u w; w.x = pk2(o[0], o[1]); w.y = pk2(o[2], o[3]); w.z = pk2(o[4], o[5]); w.w = pk2(o[6], o[7]);
                    *(GAS v4u*)(ycat + (size_t)row * D + 1024 + c8) = w; } }
        } else {
            const int oct = tid & 15, tq = tid >> 4, c8 = 8 * oct, tbase = 4 * tq, tsb = (row0 + tbase) % SEQ;
#pragma unroll
            for (int g = 0; g < 4; ++g) { constexpr int WMAX = 16; const int W = 2 << g; LAS bf16* tile = tile0 + (g & 1) * TILE_ELEMS;
                asm volatile("" ::: "memory");
                const bf16* xp = z + (size_t)(row0 + tbase) * ZP + 3584 + g * 128 + c8;
                float sw[4][8];
#pragma unroll
                for (int tt = 0; tt < 4; ++tt)
#pragma unroll
                    for (int e = 0; e < 8; ++e) sw[tt][e] = 0.f;
#pragma unroll
                for (int kb = 0; kb < WMAX + 3; kb += 8) if (kb < W + 3) { v4u rr[8];
#pragma unroll
                    for (int kk = 0; kk < 8; ++kk) if (kb + kk < W + 3) { const int back = W - 1 - (kb + kk);
                        rr[kk] = (tsb - back >= 0) ? *(const GAS v4u*)(xp - (ptrdiff_t)back * ZP) : (v4u){0u, 0u, 0u, 0u}; }
#pragma unroll
                    for (int kk = 0; kk < 8; ++kk) if (kb + kk < W + 3) { const int k = kb + kk; float x[8]; unpack8(rr[kk], x);
#pragma unroll
                        for (int tt = 0; tt < 4; ++tt) if (tt <= k && k <= tt + W - 1) {
#pragma unroll
                            for (int e = 0; e < 8; ++e) sw[tt][e] += x[e];
                            if (k == tt + W - 1) {
                                const int ts = tsb + tt, cnt = (ts + 1 < W) ? ts + 1 : W; const float ic = 1.0f / (float)cnt; v4u o;
                                o.x = pk2(sw[tt][0] * ic - x[0], sw[tt][1] * ic - x[1]); o.y = pk2(sw[tt][2] * ic - x[2], sw[tt][3] * ic - x[3]);
                                o.z = pk2(sw[tt][4] * ic - x[4], sw[tt][5] * ic - x[5]); o.w = pk2(sw[tt][6] * ic - x[6], sw[tt][7] * ic - x[7]);
                                *(LAS v4u*)(tile + (tbase + tt) * TP + c8) = o; } } }
                    asm volatile("" ::: "memory"); }
                bf16x8 wf[4];
#pragma unroll
                for (int kk = 0; kk < 4; ++kk) wf[kk] = *(const GAS bf16x8*)(poolwt + ((size_t)g * 128 + 16 * wave + fr) * 128 + kk * 32 + 8 * fq);
                const f32x4 sc = *(const GAS f32x4*)(pscale + g * 128 + 16 * wave + 4 * fq);
                LDS_WAIT(); __syncthreads();
                A4 acc[8];
#pragma unroll
                for (int tt = 0; tt < 8; ++tt) acc[tt] = (A4){0.f, 0.f, 0.f, 0.f};
#pragma unroll
                for (int kk = 0; kk < 4; ++kk)
#pragma unroll
                    for (int tt = 0; tt < 8; ++tt) { const bf16x8 pf = *(const LAS bf16x8*)(tile + (tt * 16 + fr) * TP + kk * 32 + 8 * fq);
                        acc[tt] = __builtin_amdgcn_mfma_f32_16x16x32_bf16(wf[kk], pf, acc[tt], 0, 0, 0); }
#pragma unroll
                for (int tt = 0; tt < 8; ++tt) { const int row = row0 + tt * 16 + fr;
                    v2u o; o.x = pk2(acc[tt][0] * sc.x, acc[tt][1] * sc.y); o.y = pk2(acc[tt][2] * sc.z, acc[tt][3] * sc.w);
                    *(GAS v2u*)(ycat + (size_t)row * D + 1536 + g * 128 + 16 * wave + 4 * fq) = o; }
            }
        }
        LDS_WAIT(); __syncthreads();
    }
}
__device__ __forceinline__ void final_row(const bf16* __restrict__ h, float* __restrict__ out, const float* __restrict__ g, int m, int lane) {
    const bf16* hr = h + (size_t)m * D; float* orow = out + (size_t)m * D; v4u w[4]; float s = 0.f;
#pragma unroll
    for (int j = 0; j < 4; ++j) { w[j] = *(const GAS v4u*)(hr + 512 * j + 8 * lane); s += sumsqh8(w[j]); }
    const float ri = 1.0f / sqrtf(wave_sum(s) * (1.0f / (float)D) + EPS);
#pragma unroll
    for (int j = 0; j < 4; ++j) { const f32x4 g0 = *(const GAS f32x4*)(g + 512 * j + 8 * lane), g1 = *(const GAS f32x4*)(g + 512 * j + 8 * lane + 4);
        *(GAS f32x4*)(orow + 512 * j + 8 * lane) = (f32x4){hlo(w[j].x), hhi(w[j].x), hlo(w[j].y), hhi(w[j].y)} * ri * g0;
        *(GAS f32x4*)(orow + 512 * j + 8 * lane + 4) = (f32x4){hlo(w[j].z), hhi(w[j].z), hlo(w[j].w), hhi(w[j].w)} * ri * g1; }
}
__device__ __forceinline__ void final_phase(Frame& F, const bf16* __restrict__ h, float* __restrict__ out, const float* __restrict__ g) {
    int tid_ = threadIdx.x; asm volatile("" : "+v"(tid_));
    const int lane = tid_ & 63, wave = __builtin_amdgcn_readfirstlane(tid_ >> 6);
    if (F.G == 256) {
        const int base = (F.vcu >> 5) * 2048 + (F.vcu & 31) * NWAVES + wave;
        for (int jj = 0; jj < 8; ++jj) final_row(h, out, g, base + 256 * jj, lane);
    } else { const int gw = F.vcu * NWAVES + wave, NGW = F.G * NWAVES; for (int m = gw; m < M; m += NGW) final_row(h, out, g, m, lane); }
}
struct Args { InPtrs in; float* out; unsigned char* ws; };
#ifndef MK_ONLY
#define MK_ONLY -1
#endif
#define PH(k) (MK_ONLY < 0 || MK_ONLY == (k))
#ifndef MK_DUP1_STEPA
#define MK_DUP1_STEPA 0
#endif
#ifndef MK_DUP1_STEP
#define MK_DUP1_STEP 1
#endif
#ifndef MK_WIDE3
#define MK_WIDE3 0
#endif
#ifndef MK_WIDE5
#define MK_WIDE5 0
#endif
#ifndef MK_WIDE9
#define MK_WIDE9 0
#endif
#ifndef MK_DUP
#define MK_DUP -1
#endif
__global__ void __launch_bounds__(NWAVES * 64, 2) mk_fwd(Args args) {
    extern __shared__ __attribute__((aligned(16))) unsigned char lds[];
    Frame F;
    F.lds = (LAS unsigned char*)lds;
    F.MISC = (volatile LAS unsigned*)(F.lds + MISC_OFF);
    F.tid = threadIdx.x; F.lane = F.tid & 63; F.wave = __builtin_amdgcn_readfirstlane(F.tid >> 6);
    F.G = gridDim.x; { const int bx = blockIdx.x; F.vcu = (F.G % 8 == 0) ? (bx % 8) * (F.G / 8) + bx / 8 : bx; }
    unsigned char* ws = args.ws;
    F.ctl = (gu32*)(ws + WS_CTL);
    for (int u = F.tid; u < (LDS_BYTES - LDSCTL_OFF) / 4; u += NWAVES * 64) ((LAS unsigned*)(F.lds + LDSCTL_OFF))[u] = 0u;
    __syncthreads();
    XcdBarrier bar; bar.bar = (unsigned*)(ws + WS_CTL) + CW_BAR; bar.x = xb_xcc_id(); bar.st = F.MISC + 8;
    if (F.tid == 0) F.MISC[11] = xb_add(&bar.bar[XB_XCNT(bar.x)], 1u);
    __syncthreads();
    const int xcc = __builtin_amdgcn_readfirstlane((int)bar.x), xrank = __builtin_amdgcn_readfirstlane((int)F.MISC[11]);
#define localmode ((int)F.MISC[12])
    u64* const ssb0 = (u64*)(ws + WS_CTL + SS_OFF);
#define ssb   ((u64*)(ws + WS_CTL + SS_OFF))
#define out   (args.out)
#define HB    ((bf16*)(ws + WS_HB))
#define HB2   ((bf16*)(ws + WS_HB2))
#define ZH    ((bf16*)(ws + WS_ZH))
#define YCAT  ((bf16*)(ws + WS_YCAT))
#define MB    ((bf16*)(ws + WS_MB))
#define PT    ((bf16*)(ws + WS_MTMP))
#define HID   ((bf16*)(ws + WS_HID))
#define HB8   (ws + WS_HB8)
#define HB8B  (ws + WS_HB8B)
#define WSC   ((const float*)(ws + WS_SC) + M)
#define ASCALE ((float*)(ws + WS_SC))
#define DUMF  ((float*)(ws + WS_DUM))
#define DUMB  ((bf16*)(ws + WS_MTMP))
#define wl    ((const unsigned char*)(ws + WS_W + (size_t)l * LAYER_W))
#define ss0   (ssb + (size_t)(4 * l) * M)
#define ss1   (ssb + (size_t)(4 * l + 1) * M)
#define ss2   (ssb + (size_t)(4 * l + 2) * M)
#define ss3   (ssb + (size_t)(4 * l + 3) * M)
#define ss4   (ssb + (size_t)(4 * l + 4) * M)
#define LAUNDER_WS() do { unsigned long long w_ = (unsigned long long)args.ws; asm volatile("" : "+s"(w_)); ws = (unsigned char*)w_; asm volatile("" : "+s"(ord)); } while (0)
    const int G = F.G; int ord = (int)blockIdx.x;
#ifndef MK_TPROBE
#define MK_TPROBE 0
#endif
    unsigned long long tp_acc = 0ull, tp_prev = MK_TPROBE ? __builtin_amdgcn_s_memrealtime() : 0ull;
    const unsigned long long tp_c0 = (MK_TPROBE == 500) ? __builtin_amdgcn_s_memtime() : 0ull, tp_r0 = tp_prev;
#define SEAM(k) do { if (localmode && (k) != 0 && (k) != 2 && (k) != 3) xcd_local_barrier(bar); else xcd_barrier(bar); } while (0)
#define PHASE_END(k) do { if (MK_TPROBE) { const unsigned long long ta_ = __builtin_amdgcn_s_memrealtime(); SEAM(k); const unsigned long long te_ = __builtin_amdgcn_s_memrealtime(); \
        if (MK_TPROBE == 100 + (k)) tp_acc += ta_ - tp_prev; if (MK_TPROBE == 200 || MK_TPROBE == 300 + (k) || (MK_TPROBE == 201 && (k) != 0 && (k) != 2 && (k) != 3) || (MK_TPROBE == 202 && ((k) == 2 || (k) == 3))) tp_acc += te_ - ta_; tp_prev = te_; } else SEAM(k); LAUNDER_WS(); } while (0)

    if (PH(0)) p0_prologue(F, args.in, ws, ssb0);
    PHASE_END(0);
    if (MK_DUP == 0) { p0_prologue(F, args.in, ws, ssb0); PHASE_END(0); }
    {
        if (F.tid == 0) { unsigned ok = (G == 256) ? 1u : 0u, npop = 0u;
            for (unsigned j = 0; j < 16; ++j) { const unsigned c = xb_ld(&bar.bar[XB_XCNT(j)]); if (c != 0u) { ++npop; if (c != 32u || j >= 8u) ok = 0u; } }
#if defined(MK_FORCE_GLOBAL)
            ok = 0u;
#endif
            F.MISC[12] = (ok && npop == 8u) ? 1u : 0u; }
        __syncthreads();
        if (localmode) { ord = __builtin_amdgcn_readfirstlane(xrank * 8 + xcc); F.vcu = __builtin_amdgcn_readfirstlane(xcc * 32 + xrank); }
    }
#ifndef MK_GATE_I8
#define MK_GATE_I8 1
#endif

    for (int l = 0; l < DEPTH; ++l) {
        if (PH(1))
        { SchedPlain S; S.T.init(M, 2 * FF, G, ord); S.A = (const char*)HB8B; S.B = (const char*)(wl + OW_GU1); S.astep = (size_t)256 * D; S.bstep = (size_t)256 * D * 2; S.nt = D / 128; S.T.wide = 1;
          EpiSwiglu8 E{HID, ss0, ssb + (size_t)(l == 0 ? 0 : 4 * l - 1) * M, WSC + DEPTH * (NGATE + D) + (l * 2 + 0) * (2 * FF)}; pg8::gemm_phase<EpiSwiglu8, SchedPlain, true>(F.lds + RING_OFF, D / 2, D, S, E); }
        PHASE_END(1);
        if (PH(2))
        { SchedPlain S; S.T.init(M, D, G, ord); S.A = (const char*)HID; S.B = (const char*)(wl + OW_D1); S.astep = (size_t)256 * FFP * 2; S.bstep = (size_t)256 * FF * 2; S.nt = FF / 64; S.T.wide = 1;
          EpiResid E{HB2, HB, ss1, nullptr, nullptr, ws + WS_HBB, 0.5f}; pg8::gemm_phase(F.lds + RING_OFF, 64, FF, S, E, 32768); }
        if (MK_GATE_I8) { PHASE_END(1); quant_h_phase(F, HB, HB8, ASCALE); }
        PHASE_END(2);
        if (MK_DUP == 1) {
        { SchedPlain S; S.T.init(M, 2 * FF, G, ord); S.A = (const char*)HB8B; S.B = (const char*)(wl + OW_GU1); S.astep = (size_t)256 * D * MK_DUP1_STEPA; S.bstep = (size_t)256 * D * 2 * MK_DUP1_STEP; S.nt = D / 128;
          EpiSwiglu8 E{HID, ss0, ssb + (size_t)(l == 0 ? 0 : 4 * l - 1) * M, WSC + DEPTH * (NGATE + D) + (l * 2 + 0) * (2 * FF)}; pg8::gemm_phase<EpiSwiglu8, SchedPlain, true>(F.lds + RING_OFF, D / 2, D, S, E); }
        PHASE_END(1); }
        if (MK_DUP == 2) {
        { SchedPlain S; S.T.init(M, D, G, ord); S.A = (const char*)HID; S.B = (const char*)(wl + OW_D1); S.astep = (size_t)256 * FFP * 2; S.bstep = (size_t)256 * FF * 2; S.nt = FF / 64;
          EpiResid E{HB2, DUMB, ssb + (size_t)17 * M, nullptr, nullptr, nullptr, 0.5f}; pg8::gemm_phase(F.lds + RING_OFF, 64, FF, S, E, 32768); }
        PHASE_END(2); }
        if (PH(3)) {
        { SchedPlain S; S.T.init(M, 4096, G, ord); S.A = (const char*)(ws + WS_HBB); S.B = (const char*)(wl + OW_IN); S.astep = (size_t)256 * D * 2; S.bstep = (size_t)256 * D * 2; S.nt = D / 64; S.T.wide = MK_WIDE3;
          EpiWin E{ZH, ss1, 0}; pg8::gemm_phase(F.lds + RING_OFF, D, D, S, E); }
        if (MK_GATE_I8) {
          SchedPlain S; S.T.init(M, NGATE, G, ord); S.A = (const char*)HB8; S.B = (const char*)(wl + OW_IN) + (size_t)4096 * D * 2; S.astep = (size_t)256 * D; S.bstep = (size_t)256 * D * 2; S.nt = D / 128; S.T.wide = MK_WIDE3;
          EpiGate8 E{ZH, ss1, ASCALE, (const float*)(ws + WS_SC) + M + l * NGATE}; pg8::gemm_phase<EpiGate8, SchedPlain, true>(F.lds + RING_OFF, D / 2, D, S, E);
        }
        }
        PHASE_END(3);
        if (MK_DUP == 3) {
        { SchedPlain S; S.T.init(M, NIN, G, ord); S.A = (const char*)HB; S.B = (const char*)(wl + OW_IN); S.astep = (size_t)256 * D * 2; S.bstep = (size_t)256 * D * 2; S.nt = D / 64;
          EpiWin E{ZH, ss1, 0}; pg8::gemm_phase(F.lds + RING_OFF, D, D, S, E); }
        PHASE_END(3); }
        if (PH(4))
        mixer_phase(F, ZH, YCAT, args.in.p[8] + l * 1024, args.in.p[9] + l * 1024, (const bf16*)(wl + OW_SGU), args.in.p[11] + l * 1024, args.in.p[12] + l * 1536, (const bf16*)(wl + OW_POOL), args.in.p[14] + l * 512);
        PHASE_END(4);
        if (MK_DUP == 4) {
        mixer_phase(F, ZH, YCAT, args.in.p[8] + l * 1024, args.in.p[9] + l * 1024, (const bf16*)(wl + OW_SGU), args.in.p[11] + l * 1024, args.in.p[12] + l * 1536, (const bf16*)(wl + OW_POOL), args.in.p[14] + l * 512);
        PHASE_END(4); }
        if (PH(5))
        { SchedBranch S; S.T.init(M, D, G, ord); S.A = (const char*)YCAT; S.B = (const char*)(wl + OW_BR); S.astep = (size_t)256 * D * 2; S.bstep = (size_t)256 * D * 2; S.T.wide = MK_WIDE5;
          EpiBranch E{ZH, MB}; pg8::gemm_phase(F.lds + RING_OFF, D, D, S, E); }
        PHASE_END(5);
        if (MK_DUP == 5) {
        { SchedBranch S; S.T.init(M, D, G, ord); S.A = (const char*)YCAT; S.B = (const char*)(wl + OW_BR); S.astep = (size_t)256 * D * 2; S.bstep = (size_t)256 * D * 2;
          EpiBranch E{ZH, MB}; pg8::gemm_phase(F.lds + RING_OFF, D, D, S, E); }
        PHASE_END(5); }
        if (PH(6))
        { SchedPlain S; S.T.init(M, D, G, ord); S.A = (const char*)MB; S.B = (const char*)(wl + OW_OUT); S.astep = (size_t)256 * D * 2; S.bstep = (size_t)256 * D * 2; S.nt = D / 64; S.T.wide = MK_WIDE5;
          EpiResid E{HB, HB, ss2, HB8B, ss1, nullptr, 1.0f}; pg8::gemm_phase(F.lds + RING_OFF, D, D, S, E); }
        PHASE_END(6);
        if (MK_DUP == 6) {
        { SchedPlain S; S.T.init(M, D, G, ord); S.A = (const char*)MB; S.B = (const char*)(wl + OW_OUT); S.astep = (size_t)256 * D * 2; S.bstep = (size_t)256 * D * 2; S.nt = D / 64;
          EpiResid E{HB, DUMB, ssb + (size_t)17 * M, nullptr, nullptr, nullptr, 1.0f}; pg8::gemm_phase(F.lds + RING_OFF, D, D, S, E); }
        PHASE_END(6); }
        if (PH(7))
        { SchedPlain S; S.T.init(M, 2 * FF, G, ord); S.A = (const char*)HB8B; S.B = (const char*)(wl + OW_GU2); S.astep = (size_t)256 * D; S.bstep = (size_t)256 * D * 2; S.nt = D / 128; S.T.wide = 1;
          EpiSwiglu8 E{HID, ss2, ss1, WSC + DEPTH * (NGATE + D) + (l * 2 + 1) * (2 * FF)}; pg8::gemm_phase<EpiSwiglu8, SchedPlain, true>(F.lds + RING_OFF, D / 2, D, S, E); }
        PHASE_END(7);
        if (PH(8))
        { SchedPlain S; S.T.init(M, D, G, ord); S.A = (const char*)HID; S.B = (const char*)(wl + OW_D2); S.astep = (size_t)256 * FFP * 2; S.bstep = (size_t)256 * FF * 2; S.nt = FF / 64; S.T.wide = 1;
          EpiResid E{HB, HB, ss3, HB8, ss2, nullptr, 0.5f}; pg8::gemm_phase(F.lds + RING_OFF, 64, FF, S, E, 32768); }
        PHASE_END(8);
        if (MK_DUP == 8) {
        { SchedPlain S; S.T.init(M, D, G, ord); S.A = (const char*)HID; S.B = (const char*)(wl + OW_D2); S.astep = (size_t)256 * FFP * 2; S.bstep = (size_t)256 * FF * 2; S.nt = FF / 64;
          EpiResid E{HB, DUMB, ssb + (size_t)17 * M, nullptr, nullptr, nullptr, 0.5f}; pg8::gemm_phase(F.lds + RING_OFF, 64, FF, S, E, 32768); }
        PHASE_END(8); }
        if (PH(9)) {
        { SchedPlain S; S.T.init(M, D, G, ord); S.A = (const char*)(ws + WS_PCAT) + (size_t)l * DPLE * 2; S.B = (const char*)(wl + OW_P) + (size_t)D * 2; S.astep = (size_t)256 * D * 2; S.bstep = (size_t)256 * (D + DPLE) * 2; S.nt = DPLE / 64; S.T.wide = MK_WIDE9;
          EpiProj E{PT}; pg8::gemm_phase(F.lds + RING_OFF, D, D + DPLE, S, E); }
        { SchedPlain S; S.T.init(M, D, G, ord); S.A = (const char*)HB8; S.B = (const char*)(wl + OW_P); S.astep = (size_t)256 * D; S.bstep = (size_t)256 * (D + DPLE) * 2; S.nt = D / 128; S.T.wide = MK_WIDE9;
          EpiPleGate8 E{HB, HB2, PT, ss3, ss2, WSC + DEPTH * NGATE + l * D, ss4, HB8B}; pg8::gemm_phase<EpiPleGate8, SchedPlain, true>(F.lds + RING_OFF, D / 2, D + DPLE, S, E); }
        }
        PHASE_END(9);
    }
    if (PH(10))
    final_phase(F, HB2, out, args.in.p[26]);
    if (MK_TPROBE == 500) { const unsigned long long dc = __builtin_amdgcn_s_memtime() - tp_c0, dr = __builtin_amdgcn_s_memrealtime() - tp_r0; tp_acc = (dc * 2500ull) / dr; }
    if (MK_TPROBE == 999 && localmode) tp_acc = 50000ull;
    if (MK_TPROBE) { if (MK_TPROBE == 110) tp_acc += __builtin_amdgcn_s_memrealtime() - tp_prev;
#ifndef MK_TBLOCK
#define MK_TBLOCK 0
#endif
        if (blockIdx.x == MK_TBLOCK) { const unsigned long long t0_ = __builtin_amdgcn_s_memrealtime(); while (__builtin_amdgcn_s_memrealtime() - t0_ < 4ull * tp_acc) __builtin_amdgcn_s_sleep(8); } }
#undef PHASE_END
#undef localmode
#undef ssb
#undef out
#undef HB
#undef HB2
#undef ZH
#undef YCAT
#undef MB
#undef PT
#undef HID
#undef HB8
#undef HB8B
#undef WSC
#undef ASCALE
#undef DUMF
#undef DUMB
#undef wl
#undef ss0
#undef ss1
#undef ss2
#undef ss3
#undef ss4
#undef LAUNDER_WS
}

extern "C" void kernel_launch(void* const* d_in, const int* in_sizes, int n_in, void* d_out, int out_size, void* d_ws, size_t ws_size, hipStream_t stream) {
    static int grid = 0;
    if (grid == 0) {
        if (n_in != 27 || out_size != M * D || ws_size < WS_END) { fprintf(stderr, "kernel_launch: unexpected shapes: n_in %d out %d ws %zu (need %zu); nothing launched\n", n_in, out_size, ws_size, (size_t)WS_END); grid = -1; return; }
        int dev = 0, cus = 0, per_cu = 0;
        if (hipGetDevice(&dev) != hipSuccess || hipDeviceGetAttribute(&cus, hipDeviceAttributeMultiprocessorCount, dev) != hipSuccess) { fprintf(stderr, "kernel_launch: device query failed\n"); grid = -1; return; }
        if (hipFuncSetAttribute((const void*)mk_fwd, hipFuncAttributeMaxDynamicSharedMemorySize, LDS_BYTES) != hipSuccess) { fprintf(stderr, "kernel_launch: hipFuncSetAttribute failed\n"); grid = -1; return; }
        if (hipOccupancyMaxActiveBlocksPerMultiprocessor(&per_cu, (const void*)mk_fwd, NWAVES * 64, LDS_BYTES) != hipSuccess || per_cu < 1) { fprintf(stderr, "kernel_launch: occupancy query reports %d blocks per CU\n", per_cu); }
        (void)hipGetLastError();
        grid = cus;
    }
    if (grid < 0) return;
    if (hipMemsetAsync((char*)d_ws + WS_CTL, 0, CTL_ZERO_BYTES, stream) != hipSuccess) { fprintf(stderr, "kernel_launch: memset failed\n"); return; }
    Args a{};
    for (int i = 0; i < 27; ++i) a.in.p[i] = (const float*)d_in[i];
    a.out = (float*)d_out; a.ws = (unsigned char*)d_ws;
    hipLaunchKernelGGL(mk_fwd, dim3(grid), dim3(NWAVES * 64), LDS_BYTES, stream, a);
    const hipError_t le = hipPeekAtLastError();
    if (le != hipSuccess) fprintf(stderr, "kernel_launch: launch failed: %s\n", hipGetErrorName(le));
}
```

```cpp
#include <hip/hip_runtime.h>
#include <cstdio>
#include <cstdint>
namespace pg8 {
#define PG8_LAS __attribute__((address_space(3)))
typedef unsigned short bf16_t;
typedef short bf16x8 __attribute__((ext_vector_type(8)));
typedef float f32x4 __attribute__((ext_vector_type(4)));
typedef float f32x2 __attribute__((ext_vector_type(2)));
typedef unsigned u32x4 __attribute__((ext_vector_type(4)));
typedef unsigned u32x2 __attribute__((ext_vector_type(2)));
constexpr int BM = 256, BK = 64, HALF = 128, HTB = HALF * BK * 2  , STAGE_BYTES = 8 * HTB, NXCD = 8, WGM = 8;

__host__ __device__ __forceinline__ int lds_byte(int r, int c) { const int st = (r >> 4) * 2 + (c >> 5), rr = r & 15, cc = c & 31, ob = rr * 64 + cc * 2; return st * 1024 + (ob ^ (((ob >> 9) & 1) << 5)); }
__host__ __device__ __forceinline__ void stage_rc(int b, int& R, int& C) { const int st = b / 1024, sb = b % 1024, swz = sb ^ (((sb >> 9) & 1) << 5); R = (st >> 1) * 16 + swz / 64; C = (st & 1) * 32 + (swz % 64) / 2; }
__host__ __device__ __forceinline__ int perm32(int rho) { const int n = rho >> 4, i = rho & 15; return 8 * (i >> 2) + 4 * n + (i & 3); }

struct Unit { const char* A; const char* B; int nt; int pm, pn, kind, keep, par; };

struct TileOrder {
    int nM, nN, nwg, G, c, wide;
    __host__ __device__ void init(int M, int N, int G_, int c_) { nM = M / BM; nN = N / BM; nwg = nM * nN; G = G_; c = c_; wide = 0; }
    __host__ __device__ bool tile(int i, int& pm, int& pn) const {
        if (G == 256 && nM == 64) {
            const int L = i * 256 + c; if (L >= nwg) return false;
            const int xl = c & 7, off = i * 32 + (c >> 3);
            if (wide) { const int r = c >> 3, sr = i >> 1;
                if (8 * sr + 8 <= nN) { pm = 8 * xl + 4 * (i & 1) + (r >> 3); pn = 8 * sr + (r & 7); } else { pm = 8 * xl + (r & 7); pn = 8 * sr + (r >> 3); }
                pn += (xl * nN) >> 3; if (pn >= nN) pn -= nN; return true; }
            pm = 8 * xl + (off & 7); pn = (off >> 3) + ((xl * nN) >> 3); if (pn >= nN) pn -= nN; return true;
        }
        const long L = (long)i * G + c; if (L >= nwg) return false;
        int wgid = (int)L; { const int q = nwg / NXCD, r = nwg % NXCD, xcd = wgid % NXCD, off = wgid / NXCD; wgid = (xcd < r ? xcd * (q + 1) : r * (q + 1) + (xcd - r) * q) + off; }
        const int nig = WGM * nN, gid = wgid / nig, fm = gid * WGM, gsz = (nM - fm) < WGM ? (nM - fm) : WGM;
        pm = fm + ((wgid % nig) % gsz); pn = (wgid % nig) / gsz;
        { const int xl = (int)(L % NXCD); pn += (xl * nN) / NXCD; if (pn >= nN) pn -= nN; }
        return true;
    }
};

__device__ __forceinline__ unsigned cvt_pk_bf16(float lo, float hi) { unsigned r; asm volatile("v_cvt_pk_bf16_f32 %0, %1, %2" : "=v"(r) : "v"(lo), "v"(hi)); return r; }
__device__ __forceinline__ f32x2 gelu_pk(f32x2 v) {
    const f32x2 av = __builtin_elementwise_abs(v), d = av * 0.2316418882f + 1.0f;
    f32x2 t; t.x = __builtin_amdgcn_rcpf(d.x); t.y = __builtin_amdgcn_rcpf(d.y);
    f32x2 q = t * 0.5307027145f + (-0.7265760135f); q = q * t + 0.7107068705f; q = q * t + (-0.142248368f); q = q * t + 0.127414796f; q = q * t;
    const f32x2 s = (v * v) * (-0.72134752044f);
    f32x2 e; e.x = __builtin_amdgcn_exp2f(s.x); e.y = __builtin_amdgcn_exp2f(s.y);
    const f32x2 m = v * (q * e), r = v - m;
    f32x2 o; o.x = v.x < 0.f ? m.x : r.x; o.y = v.y < 0.f ? m.y : r.y; return o;
}

__device__ __forceinline__ void gelu_pk4(f32x2 (&v)[4]) {
    f32x2 d[4], s[4], t[4], e[4], q[4];
#pragma unroll
    for (int i = 0; i < 4; ++i) { d[i] = __builtin_elementwise_abs(v[i]) * 0.2316418882f + 1.0f; s[i] = (v[i] * v[i]) * (-0.72134752044f); }
#pragma unroll
    for (int i = 0; i < 4; ++i) { t[i].x = __builtin_amdgcn_rcpf(d[i].x); t[i].y = __builtin_amdgcn_rcpf(d[i].y); e[i].x = __builtin_amdgcn_exp2f(s[i].x); e[i].y = __builtin_amdgcn_exp2f(s[i].y); }
#pragma unroll
    for (int i = 0; i < 4; ++i) q[i] = t[i] * 0.5307027145f + (-0.7265760135f);
#pragma unroll
    for (int i = 0; i < 4; ++i) q[i] = q[i] * t[i] + 0.7107068705f;
#pragma unroll
    for (int i = 0; i < 4; ++i) q[i] = q[i] * t[i] + (-0.142248368f);
#pragma unroll
    for (int i = 0; i < 4; ++i) q[i] = q[i] * t[i] + 0.127414796f;
#pragma unroll
    for (int i = 0; i < 4; ++i) q[i] = (q[i] * t[i]) * e[i];
#pragma unroll
    for (int i = 0; i < 4; ++i) { const f32x2 m = v[i] * q[i], r = v[i] - m; v[i].x = v[i].x < 0.f ? m.x : r.x; v[i].y = v[i].y < 0.f ? m.y : r.y; }
}

typedef int i32x4 __attribute__((ext_vector_type(4)));
template <class E> struct EpiPrefetch { static constexpr bool on = false; };
template <bool I8> struct AccOf { typedef f32x4 type; };
template <> struct AccOf<true> { typedef i32x4 type; };
template <class Epi, class Sched, bool I8 = false>
__device__ __forceinline__ void gemm_phase(PG8_LAS unsigned char* lds, const int lda, const int ldb, const Sched S, const Epi E, const int kstepA_ = BK * 2) {
    typedef typename AccOf<I8>::type ACC;
    int tid_ = threadIdx.x; asm volatile("" : "+v"(tid_));
    const int tid = tid_, wid = __builtin_amdgcn_readfirstlane(tid >> 6), lane = tid & 63, wr = wid >> 2, wc = wid & 3, fr = lane & 15, fq = lane >> 4;
    unsigned voffA[2], voffB[2];
#pragma unroll
    for (int i = 0; i < 2; ++i) { int R, C; stage_rc(tid * 16 + i * 8192, R, C); const int Rb = (R & ~31) + perm32(R & 31);
        voffA[i] = (unsigned)(R * lda + C) * 2u; voffB[i] = (unsigned)(Rb * ldb + C) * 2u; }
    const size_t kstep = (size_t)(BK * 2), kstepA = (size_t)kstepA_;
    const size_t hstepA = (size_t)HALF * lda * 2, hstepB = (size_t)HALF * ldb * 2;
    const unsigned ldsw = (unsigned)wid * 1024u;
    const int aoff = lds_byte(wr * 64 + fr, fq * 8), boff = lds_byte(wc * 32 + fr, fq * 8);
#define PG8_SA(b, h) (((b) * 2 + (h)) * HTB)
#define PG8_SB(b, h) ((4 + (b) * 2 + (h)) * HTB)
#define PG8_STAGE(bufoff, gbase, voff) do { _Pragma("unroll") for (int _i = 0; _i < 2; ++_i) \
        __builtin_amdgcn_global_load_lds((const unsigned*)((const char*)(gbase) + (voff)[_i]), (PG8_LAS unsigned*)(lds + (bufoff) + ldsw + _i * 8192), 16, 0, 0); } while (0)
#define PG8_LDA(dst, b, h) do { _Pragma("unroll") for (int m = 0; m < 4; ++m) _Pragma("unroll") for (int k = 0; k < 2; ++k) dst[m][k] = *(const PG8_LAS bf16x8*)(lds + PG8_SA(b, h) + aoff + m * 2048 + k * 1024); } while (0)
#define PG8_LDB(dst, b, h) do { _Pragma("unroll") for (int n = 0; n < 2; ++n) _Pragma("unroll") for (int k = 0; k < 2; ++k) dst[n][k] = *(const PG8_LAS bf16x8*)(lds + PG8_SB(b, h) + boff + n * 2048 + k * 1024); } while (0)
#define PG8_MMA(ai, bj, At, Bt) do { __builtin_amdgcn_s_setprio(1); _Pragma("unroll") for (int m = 0; m < 4; ++m) _Pragma("unroll") for (int n = 0; n < 2; ++n) _Pragma("unroll") for (int k = 0; k < 2; ++k) \
        { if constexpr (I8) acc[ai][bj][m][n] = __builtin_amdgcn_mfma_i32_16x16x64_i8(__builtin_bit_cast(i32x4, Bt[n][k]), __builtin_bit_cast(i32x4, At[m][k]), acc[ai][bj][m][n], 0, 0, 0); \
          else acc[ai][bj][m][n] = __builtin_amdgcn_mfma_f32_16x16x32_bf16(Bt[n][k], At[m][k], acc[ai][bj][m][n], 0, 0, 0); } __builtin_amdgcn_s_setprio(0); } while (0)
#define PG8_WAIT_V(n) asm volatile("s_waitcnt vmcnt(" #n ")" ::: "memory")
#define PG8_WAIT_L(n) asm volatile("s_waitcnt lgkmcnt(" #n ")" ::: "memory")
#define PG8_BAR __builtin_amdgcn_s_barrier()
#define PG8_SCHED __builtin_amdgcn_sched_barrier(0)
    Unit cur, nxt; int ui = 0;
    if (!S.next(0, cur)) return;
    cur.par = 0;
    if constexpr (EpiPrefetch<Epi>::on) E.prefetch(cur, tid, wid);
    ACC acc[2][2][4][2]; const ACC acc_zero = {};
#pragma unroll
    for (int a = 0; a < 2; ++a)
#pragma unroll
        for (int b = 0; b < 2; ++b)
#pragma unroll
            for (int m = 0; m < 4; ++m)
#pragma unroll
                for (int n = 0; n < 2; ++n) acc[a][b][m][n] = acc_zero;
    bf16x8 At[4][2], B0[2][2], B1[2][2];
    const char* cA = cur.A; const char* cB = cur.B;
    PG8_STAGE(PG8_SB(0, 0), cB, voffB); PG8_STAGE(PG8_SB(0, 1), cB + hstepB, voffB); PG8_STAGE(PG8_SA(0, 0), cA, voffA); PG8_STAGE(PG8_SA(0, 1), cA + hstepA, voffA);
    if (wr == 1) PG8_BAR;
    PG8_WAIT_V(2); PG8_BAR;
    PG8_STAGE(PG8_SB(1, 0), cB + kstep, voffB); PG8_STAGE(PG8_SA(1, 0), cA + kstepA, voffA); PG8_STAGE(PG8_SB(1, 1), cB + hstepB + kstep, voffB);
    PG8_WAIT_V(6); PG8_BAR;
    for (;;) {
        const bool has_next = S.next(ui + 1, nxt); nxt.par = (ui + 1) & 1;
        const char* nA = has_next ? nxt.A : cA; const char* nB = has_next ? nxt.B : cB;
        const int nt = cur.nt;
        for (int t = 0; t < nt; t += 2) {
            const bool last = (t == nt - 2);
            const char* a1 = cA + (size_t)(t + 1) * kstepA;
            const char* a2 = last ? nA : cA + (size_t)(t + 2) * kstepA; const char* b2 = last ? nB : cB + (size_t)(t + 2) * kstep;
            const char* a3 = a2 + kstepA; const char* b3 = b2 + kstep;
            PG8_LDB(B0, 0, 0); PG8_LDB(B1, 0, 1); PG8_SCHED; PG8_LDA(At, 0, 0); PG8_STAGE(PG8_SA(1, 1), a1 + hstepA, voffA);
            PG8_WAIT_V(8); PG8_WAIT_L(0); PG8_BAR; PG8_MMA(0, 0, At, B0); PG8_MMA(0, 1, At, B1); PG8_BAR; PG8_SCHED;
            PG8_LDA(At, 0, 1); PG8_STAGE(PG8_SB(0, 0), b2, voffB); PG8_STAGE(PG8_SB(0, 1), b2 + hstepB, voffB); PG8_STAGE(PG8_SA(0, 0), a2, voffA);
            PG8_WAIT_V(8); PG8_WAIT_L(0); PG8_BAR; PG8_MMA(1, 0, At, B0); PG8_MMA(1, 1, At, B1); PG8_BAR; PG8_SCHED;
            PG8_LDB(B0, 1, 0); PG8_LDB(B1, 1, 1); PG8_SCHED; PG8_LDA(At, 1, 0); PG8_STAGE(PG8_SA(0, 1), a2 + hstepA, voffA);
            PG8_WAIT_V(8); PG8_WAIT_L(0); PG8_BAR; PG8_MMA(0, 0, At, B0); PG8_MMA(0, 1, At, B1); PG8_BAR; PG8_SCHED;
            PG8_LDA(At, 1, 1); PG8_STAGE(PG8_SB(1, 0), b3, voffB); PG8_STAGE(PG8_SB(1, 1), b3 + hstepB, voffB); PG8_STAGE(PG8_SA(1, 0), a3, voffA);
            PG8_WAIT_V(8); PG8_WAIT_L(0); PG8_BAR; PG8_MMA(1, 0, At, B0); PG8_MMA(1, 1, At, B1); PG8_BAR; PG8_SCHED;
        }
        if (wr == 0) PG8_BAR;
        E(acc, cur, wr, wc, fr, fq);
        if (!has_next) break;
        if (!cur.keep) {
#pragma unroll
        for (int a = 0; a < 2; ++a)
#pragma unroll
            for (int b = 0; b < 2; ++b)
#pragma unroll
                for (int m = 0; m < 4; ++m)
#pragma unroll
                    for (int n = 0; n < 2; ++n) acc[a][b][m][n] = acc_zero;
        }
        cur = nxt; cA = nA; cB = nB; ++ui;
        if constexpr (EpiPrefetch<Epi>::on) E.prefetch(cur, tid, wid);
        if (wr == 1) PG8_BAR;
    }
    PG8_WAIT_V(0);
    PG8_BAR;
#undef PG8_SA
#undef PG8_SB
#undef PG8_STAGE
#undef PG8_LDA
#undef PG8_LDB
#undef PG8_MMA
#undef PG8_WAIT_V
#undef PG8_WAIT_L
#undef PG8_BAR
#undef PG8_SCHED
}
}
constexpr int NWAVES = 8;
constexpr int BATCH = 4, SEQ = 4096, D = 2048, DEPTH = 4, FF = 5632, NIN = 10240, DPLE = 256;
#ifndef MK_FFP
#define MK_FFP FF
#endif
constexpr int FFP = MK_FFP;
constexpr int ZP = 4096 + 6144 / 2;
constexpr int M = BATCH * SEQ;
constexpr float EPS = 1e-6f;
constexpr size_t MiB = 1u << 20;
constexpr size_t WS_CTL = 0, CTL_ZERO_BYTES = 4 * MiB;
constexpr size_t WS_W = 4 * MiB;
constexpr size_t OW_GU1 = 0, OW_D1 = 44 * MiB, OW_IN = 66 * MiB, OW_BR = 106 * MiB, OW_OUT = 114 * MiB, OW_GU2 = 122 * MiB, OW_D2 = 166 * MiB, OW_P = 188 * MiB, OW_SGU = 197 * MiB, OW_POOL = 197 * MiB + 512 * 1024, LAYER_W = 198 * MiB;
constexpr size_t WS_ZH = WS_W + DEPTH * LAYER_W;
constexpr size_t WS_HBB = WS_ZH + 224 * MiB;
constexpr size_t WS_HB = WS_HBB + 64 * MiB;
constexpr size_t WS_PCAT = WS_HB + 64 * MiB;
constexpr size_t WS_YCAT = WS_PCAT + 64 * MiB;
constexpr size_t WS_MB = WS_YCAT + 64 * MiB;
constexpr size_t WS_MTMP = WS_MB + 64 * MiB;
constexpr size_t WS_HID = WS_MTMP + 64 * MiB;
constexpr size_t WS_HB2 = WS_HID + 176 * MiB;
constexpr size_t WS_HB8 = WS_HB2 + 64 * MiB;
constexpr size_t WS_HB8B = WS_HB8 + 32 * MiB;
constexpr size_t WS_SC = WS_HB8B + 32 * MiB;
constexpr int NGATE = 6144;
constexpr float Q_SIGMAS = 5.0f;
constexpr size_t WS_DUM = WS_SC + 1 * MiB;
#if defined(MK_DUP)
constexpr size_t WS_END = WS_DUM;
#else
constexpr size_t WS_END = WS_DUM;
#endif
constexpr int CW_BAR = 4096;
constexpr size_t SS_OFF = 1 * MiB;
static_assert(SS_OFF + (size_t)18 * M * 8 <= CTL_ZERO_BYTES, "CTL words inside the memset region");
typedef unsigned long long u64;
constexpr float SS_SCALE = 1048576.0f, SS_INV = 1.0f / 1048576.0f;
constexpr int RING_OFF = 0, RING_BYTES = 131072;
constexpr int LDSCTL_OFF = RING_BYTES, MISC_OFF = LDSCTL_OFF + 320;
constexpr int LDS_BYTES = 147456;
constexpr int EPI_AREA_OFF = MISC_OFF + 2048, EPI_AREA_BYTES = 5120;
static_assert(EPI_AREA_OFF + 2 * EPI_AREA_BYTES <= LDS_BYTES, "LDS map");

#define GAS __attribute__((address_space(1)))
#define LAS __attribute__((address_space(3)))
typedef unsigned short bf16;
typedef unsigned v4u __attribute__((ext_vector_type(4)));
typedef unsigned v2u __attribute__((ext_vector_type(2)));
typedef float f32x4 __attribute__((ext_vector_type(4)));
typedef float f32x2 __attribute__((ext_vector_type(2)));
typedef short bf16x8 __attribute__((ext_vector_type(8)));
typedef GAS unsigned gu32;
#define RLX_AGENT __ATOMIC_RELAXED, __HIP_MEMORY_SCOPE_AGENT
#define LDS_WAIT() asm volatile("s_waitcnt lgkmcnt(0)" ::: "memory")
#define VM_WAIT() asm volatile("s_waitcnt vmcnt(0)" ::: "memory")
__device__ __forceinline__ unsigned f2bf(float f) { unsigned u = __builtin_bit_cast(unsigned, f); return (u + 0x7fffu + ((u >> 16) & 1u)) >> 16; }
__device__ __forceinline__ unsigned pk2(float lo, float hi) { return f2bf(lo) | (f2bf(hi) << 16); }
__device__ __forceinline__ float bflo(unsigned w) { return __builtin_bit_cast(float, w << 16); }
__device__ __forceinline__ float bfhi(unsigned w) { return __builtin_bit_cast(float, w & 0xffff0000u); }
typedef _Float16 h16x2 __attribute__((ext_vector_type(2)));
__device__ __forceinline__ unsigned pkh2(float lo, float hi) { const h16x2 v = {(_Float16)lo, (_Float16)hi}; return __builtin_bit_cast(unsigned, v); }
__device__ __forceinline__ float hlo(unsigned w) { return (float)__builtin_bit_cast(h16x2, w).x; }
__device__ __forceinline__ float hhi(unsigned w) { return (float)__builtin_bit_cast(h16x2, w).y; }
__device__ __forceinline__ float fast_sigmoid(float x) { return __builtin_amdgcn_rcpf(1.0f + __builtin_amdgcn_exp2f(-1.44269504089f * x)); }
__device__ __forceinline__ float wave_sum(float v) {
#pragma unroll
    for (int o = 1; o < 64; o <<= 1) v += __shfl_xor(v, o);
    return v;
}
#define XB_TMO      128
#define XB_XCNT(j)  (256  + 64 * (j))
#define XB_XSUB(j)  (1280 + 64 * (j))
#define XB_XGEN(j)  (2304 + 64 * (j))
#define XB_TOP      3328
#define XB_TOPGEN   3392
#define XCD_BAR_WORDS 3456
#define XB_SPIN_CAP (1u << 18)

__device__ __forceinline__ unsigned xb_ld(unsigned* p)              { return __hip_atomic_load(p, __ATOMIC_RELAXED, __HIP_MEMORY_SCOPE_AGENT); }
__device__ __forceinline__ unsigned xb_add(unsigned* p, unsigned v) { return __hip_atomic_fetch_add(p, v, __ATOMIC_RELAXED, __HIP_MEMORY_SCOPE_AGENT); }
__device__ __forceinline__ unsigned xb_xcc_id() { return (unsigned)__builtin_amdgcn_s_getreg((3 << 11) | 20) & 0xFu; }
#define XB_SPIN(cond, bar) do { unsigned _sp = 0; while (cond) { __builtin_amdgcn_s_sleep(1); \
    if ((++_sp & 255u) == 0u) { if (xb_ld(&(bar)[XB_TMO])) break; if (_sp > XB_SPIN_CAP) { atomicAdd(&(bar)[XB_TMO], 1u); break; } } } } while (0)

struct XcdBarrier {
    unsigned* bar; unsigned x;
    volatile LAS unsigned* st;
};

__device__ __forceinline__ XcdBarrier xcd_barrier_post(unsigned* bar, volatile LAS unsigned* st) {
    XcdBarrier b; b.bar = bar; b.x = xb_xcc_id(); b.st = st;
    if (threadIdx.x == 0) (void)xb_add(&bar[XB_XCNT(b.x)], 1u);
    return b;
}
__device__ __forceinline__ void xcd_barrier_complete(unsigned* bar, unsigned x, unsigned& nloc, unsigned& nx) {
    const unsigned G = gridDim.x * gridDim.y * gridDim.z;
    unsigned sum, cnt, mine, sp = 0u;
    for (;;) {
        sum = 0u; cnt = 0u; mine = 0u;
#pragma unroll
        for (unsigned j = 0; j < 16; ++j) { const unsigned c = xb_ld(&bar[XB_XCNT(j)]); sum += c; cnt += (c > 0u) ? 1u : 0u; mine = (j == x) ? c : mine; }
        if (sum == G) break;
        __builtin_amdgcn_s_sleep(1);
        if ((++sp & 255u) == 0u) { if (xb_ld(&bar[XB_TMO])) break; if (sp > XB_SPIN_CAP) { atomicAdd(&bar[XB_TMO], 1u); break; } }
    }
    nloc = mine > 0u ? mine : 1u; nx = cnt > 0u ? cnt : 1u;
}

__device__ __forceinline__ void xcd_barrier(const XcdBarrier& b) {
    asm volatile("s_waitcnt vmcnt(0)" ::: "memory");
    __syncthreads();
    if (threadIdx.x == 0) {
        unsigned* bar = b.bar;
        unsigned bx = b.x; asm volatile("" : "+s"(bx));
        __builtin_amdgcn_s_waitcnt(0);
        unsigned nloc = b.st[0], nx = b.st[1];
        if (nloc == 0u) { xcd_barrier_complete(bar, bx, nloc, nx); b.st[0] = nloc; b.st[1] = nx; }
        const unsigned old = xb_add(&bar[XB_XSUB(bx)], 1u);
        const unsigned gen = old / nloc;
        if (old + 1u == (gen + 1u) * nloc) {
            __builtin_amdgcn_fence(__ATOMIC_RELEASE, "agent");
            asm volatile("s_waitcnt vmcnt(0)" ::: "memory");
            const unsigned og = xb_add(&bar[XB_TOP], 1u);
            const unsigned tg = og / nx;
            if (og + 1u == (tg + 1u) * nx) xb_add(&bar[XB_TOPGEN], 1u);
            else XB_SPIN(xb_ld(&bar[XB_TOPGEN]) == tg, bar);
            __builtin_amdgcn_fence(__ATOMIC_ACQUIRE, "agent");
            xb_add(&bar[XB_XGEN(bx)], 1u);
            asm volatile("s_waitcnt vmcnt(0)" ::: "memory");
        } else {
            XB_SPIN(xb_ld(&bar[XB_XGEN(bx)]) == gen, bar);
            __builtin_amdgcn_fence(__ATOMIC_ACQUIRE, "agent");
            asm volatile("s_waitcnt vmcnt(0)" ::: "memory");
        }
    }
    __syncthreads();
}


#define XB_LSUB(j)  (3520 + 64 * (j))
#define XB_LGEN(j)  (4544 + 64 * (j))
#define XCD_BAR_WORDS_EXT 5568
__device__ __forceinline__ void xcd_local_barrier(const XcdBarrier& b) {
    asm volatile("s_waitcnt vmcnt(0)" ::: "memory");
    __syncthreads();
    if (threadIdx.x == 0) {
        unsigned* bar = b.bar;
        unsigned bx = b.x; asm volatile("" : "+s"(bx));
        __builtin_amdgcn_s_waitcnt(0);
        const unsigned nloc = b.st[0];
        const unsigned old = xb_add(&bar[XB_LSUB(bx)], 1u);
        const unsigned gen = old / nloc;
        if (old + 1u == (gen + 1u) * nloc) xb_add(&bar[XB_LGEN(bx)], 1u);
        else XB_SPIN(xb_ld(&bar[XB_LGEN(bx)]) == gen, bar);
        __builtin_amdgcn_fence(__ATOMIC_ACQUIRE, "agent");
        asm volatile("s_waitcnt vmcnt(0)" ::: "memory");
    }
    __syncthreads();
}
struct Frame {
    LAS unsigned char* lds;
    volatile LAS unsigned* MISC;
    gu32* ctl;
    int tid, lane, wave;
    int vcu, G;
};

struct XItem { const float* W; const float* gv; bf16* WT; int ldw, dpitch, k0, n0; };
__device__ __forceinline__ void xitem_load(const XItem& x, int lane, f32x4 (&v)[8], float (&g)[8]) {
    const int kr = lane >> 3, n4 = (lane & 7) * 4;
#pragma unroll
    for (int i = 0; i < 8; ++i) { v[i] = *(const GAS f32x4*)(x.W + (size_t)(x.k0 + 8 * i + kr) * x.ldw + x.n0 + n4); g[i] = x.gv ? x.gv[x.k0 + 8 * i + kr] : 1.0f; }
}
__device__ __forceinline__ void xitem_store(const XItem& x, int lane, const f32x4 (&v)[8], const float (&g)[8], LAS float* scr) {
    const int kr = lane >> 3, n4 = (lane & 7) * 4;
#pragma unroll
    for (int i = 0; i < 8; ++i) { LAS float* s = scr + (8 * i + kr) * 33 + n4; s[0] = v[i].x * g[i]; s[1] = v[i].y * g[i]; s[2] = v[i].z * g[i]; s[3] = v[i].w * g[i]; }
    LDS_WAIT(); asm volatile("" ::: "memory");
    const int c = lane & 7;
#pragma unroll
    for (int j = 0; j < 4; ++j) { const int n = (lane >> 3) + 8 * j; const LAS float* s = scr + (8 * c) * 33 + n;
        v4u o; o.x = pk2(s[0 * 33], s[1 * 33]); o.y = pk2(s[2 * 33], s[3 * 33]); o.z = pk2(s[4 * 33], s[5 * 33]); o.w = pk2(s[6 * 33], s[7 * 33]);
        *(GAS v4u*)(x.WT + (size_t)n * x.dpitch + x.k0 + 8 * c) = o; }
    LDS_WAIT(); asm volatile("" ::: "memory");
}
struct InPtrs { const float* p[27]; };
constexpr int IT_DN = (FF / 64) * (D / 32), IT_IN = (D / 64) * (4096 / 32)  , IT_BA = (1024 / 64) * (D / 32), IT_BB = (512 / 64) * (D / 32),
              IT_DD = (D / 64) * (D / 32), IT_PP = (DPLE / 64) * (D / 32), IT_PL = 4 * 2 * 4;
constexpr int IT_LAYER = 2 * IT_DN + IT_IN + IT_BA + 2 * IT_BB + IT_DD + IT_PP + IT_PL;
__device__ __forceinline__ void xmat(XItem& x, int mode, const float* W, int N, const float* gv, bf16* WT, int dpitch, int dk, int item) {
    const int nblk = N / 32, kb = item / nblk, nbk = item - kb * nblk, n0 = 32 * nbk;
    const int drow = (mode == 0) ? n0 : (256 * (n0 >> 7) + 128 * (mode - 1) + (n0 & 127));
    x.W = W; x.gv = gv; x.WT = WT + (size_t)drow * dpitch + dk; x.ldw = N; x.dpitch = dpitch; x.k0 = 64 * kb; x.n0 = n0;
}
__device__ __forceinline__ void xdecode(XItem& x, const InPtrs& I, unsigned char* ws, int it) {
    const int l = it / IT_LAYER; int r = it - l * IT_LAYER;
    unsigned char* wl = ws + WS_W + (size_t)l * LAYER_W;
    if (r < IT_DN) { xmat(x, 0, I.p[5] + (size_t)l * FF * D, D, nullptr, (bf16*)(wl + OW_D1), FF, 0, r); return; } r -= IT_DN;
    if (r < IT_IN) { const int nblk = 4096 / 32, kb = r / nblk, nbk = r - kb * nblk;
        x.W = I.p[7] + (size_t)l * D * NIN; x.gv = I.p[6] + l * D; x.WT = (bf16*)(wl + OW_IN) + (size_t)(32 * nbk) * D; x.ldw = NIN; x.dpitch = D; x.k0 = 64 * kb; x.n0 = 32 * nbk; return; } r -= IT_IN;
    if (r < IT_BA) { xmat(x, 0, I.p[15] + (size_t)l * 1024 * D, D, nullptr, (bf16*)(wl + OW_BR), D, 0, r); return; } r -= IT_BA;
    if (r < IT_BB) { xmat(x, 0, I.p[16] + (size_t)l * 512 * D, D, nullptr, (bf16*)(wl + OW_BR), D, 1024, r); return; } r -= IT_BB;
    if (r < IT_BB) { xmat(x, 0, I.p[17] + (size_t)l * 512 * D, D, nullptr, (bf16*)(wl + OW_BR), D, 1536, r); return; } r -= IT_BB;
    if (r < IT_DD) { xmat(x, 0, I.p[18] + (size_t)l * D * D, D, nullptr, (bf16*)(wl + OW_OUT), D, 0, r); return; } r -= IT_DD;
    if (r < IT_DN) { xmat(x, 0, I.p[22] + (size_t)l * FF * D, D, nullptr, (bf16*)(wl + OW_D2), FF, 0, r); return; } r -= IT_DN;
    if (r < IT_PP) { xmat(x, 0, I.p[25] + (size_t)l * DPLE * D, D, nullptr, (bf16*)(wl + OW_P), D + DPLE, D, r); return; } r -= IT_PP;
    { const int g = r >> 3, rr = r & 7; xmat(x, 0, I.p[13] + ((size_t)l * 4 + g) * 128 * 128, 128, nullptr, (bf16*)(wl + OW_POOL) + (size_t)g * 128 * 128, 128, 0, rr); }
}
constexpr int SL_FF = FF / 32, SL_G = 6144 / 32, SL_P = D / 32, SL_LAYER = 4 * SL_FF + SL_G + SL_P;
struct Slab { const float* W; const float* gv; unsigned char* dst; float* sc; int ldw, dpitch, n0; };
__device__ __forceinline__ void slab_decode(Slab& b, const InPtrs& I, unsigned char* ws, int s) {
    const int l = s / SL_LAYER; int r = s - l * SL_LAYER;
    unsigned char* wl = ws + WS_W + (size_t)l * LAYER_W; float* const sc = (float*)(ws + WS_SC) + M;
    if (r < 4 * SL_FF) { const int f = r / (2 * SL_FF), up = (r / SL_FF) & 1, nb = r % SL_FF, n0 = 32 * nb, drow = 256 * (n0 >> 7) + 128 * up + (n0 & 127);
        b.W = I.p[f ? (up ? 21 : 20) : (up ? 4 : 3)] + (size_t)l * D * FF; b.gv = I.p[f ? 19 : 2] + l * D; b.ldw = FF; b.n0 = n0; b.dpitch = D * 2;
        b.dst = wl + (f ? OW_GU2 : OW_GU1) + (size_t)drow * (D * 2); b.sc = sc + DEPTH * (6144 + D) + (l * 2 + f) * (2 * FF) + drow; return; }
    r -= 4 * SL_FF;
    if (r < SL_G) { b.W = I.p[7] + (size_t)l * D * NIN; b.gv = I.p[6] + l * D; b.ldw = NIN; b.n0 = 4096 + 32 * r; b.dpitch = D * 2;
        b.dst = wl + OW_IN + (size_t)(4096 + 32 * r) * (D * 2); b.sc = sc + l * 6144 + 32 * r; return; }
    r -= SL_G;
    b.W = I.p[24] + (size_t)l * D * D; b.gv = I.p[23] + l * D; b.ldw = D; b.n0 = 32 * r; b.dpitch = (D + DPLE) * 2;
    b.dst = wl + OW_P + (size_t)(32 * r) * ((D + DPLE) * 2); b.sc = sc + DEPTH * 6144 + l * D + 32 * r;
}
__device__ __forceinline__ void slab_pass(Frame& F, const InPtrs& I, unsigned char* ws) {
    LAS bf16* slab = (LAS bf16*)(F.lds + RING_OFF);
    LAS float* cm = (LAS float*)(F.lds + MISC_OFF + 128);
    const int lane = F.lane, wave = F.wave, kr = lane >> 3, n4 = (lane & 7) * 4;
    for (int s = F.vcu; s < DEPTH * SL_LAYER; s += F.G) {
        Slab b; slab_decode(b, I, ws, s);
        float cmax[4] = {0.f, 0.f, 0.f, 0.f};
        f32x4 va[8], vb[8]; float ga[8], gb[8];
#define SLAB_LOAD(v, g, kb) do { _Pragma("unroll") for (int i = 0; i < 8; ++i) { const int k = 64 * (kb) + 8 * i + kr; v[i] = *(const GAS f32x4*)(b.W + (size_t)k * b.ldw + b.n0 + n4); g[i] = b.gv[k]; } } while (0)
#define SLAB_PUT(v, g, kb) do { _Pragma("unroll") for (int i = 0; i < 8; ++i) { const int k = 64 * (kb) + 8 * i + kr; const float x[4] = {v[i].x * g[i], v[i].y * g[i], v[i].z * g[i], v[i].w * g[i]}; \
            _Pragma("unroll") for (int j = 0; j < 4; ++j) { const unsigned hb = f2bf(x[j]); slab[(n4 + j) * 2048 + k] = (bf16)hb; cmax[j] = fmaxf(cmax[j], fabsf(bflo(hb))); } } } while (0)
        SLAB_LOAD(va, ga, wave);
        SLAB_LOAD(vb, gb, wave + 8);  SLAB_PUT(va, ga, wave);
        SLAB_LOAD(va, ga, wave + 16); SLAB_PUT(vb, gb, wave + 8);
        SLAB_LOAD(vb, gb, wave + 24); SLAB_PUT(va, ga, wave + 16);
        SLAB_PUT(vb, gb, wave + 24);
#undef SLAB_LOAD
#undef SLAB_PUT
#pragma unroll
        for (int j = 0; j < 4; ++j) { float c = cmax[j]; c = fmaxf(c, __shfl_xor(c, 8)); c = fmaxf(c, __shfl_xor(c, 16)); c = fmaxf(c, __shfl_xor(c, 32)); if (kr == 0) cm[wave * 32 + n4 + j] = c; }
        LDS_WAIT(); __syncthreads();
#pragma unroll
        for (int rr = 0; rr < 4; ++rr) { const int n = 4 * wave + rr; float amax = 0.f;
#pragma unroll
            for (int w = 0; w < 8; ++w) amax = fmaxf(amax, cm[w * 32 + n]);
            const float sq = amax > 0.f ? 127.0f / amax : 0.f; unsigned q[8];
#pragma unroll
            for (int j = 0; j < 4; ++j) { const v4u w4 = *(const LAS v4u*)(slab + n * 2048 + 32 * lane + 8 * j); float t[8]; t[0] = bflo(w4.x); t[1] = bfhi(w4.x); t[2] = bflo(w4.y); t[3] = bfhi(w4.y); t[4] = bflo(w4.z); t[5] = bfhi(w4.z); t[6] = bflo(w4.w); t[7] = bfhi(w4.w);
                q[2 * j] = ((unsigned)(int)rintf(t[0] * sq) & 0xffu) | (((unsigned)(int)rintf(t[1] * sq) & 0xffu) << 8) | (((unsigned)(int)rintf(t[2] * sq) & 0xffu) << 16) | (((unsigned)(int)rintf(t[3] * sq) & 0xffu) << 24);
                q[2 * j + 1] = ((unsigned)(int)rintf(t[4] * sq) & 0xffu) | (((unsigned)(int)rintf(t[5] * sq) & 0xffu) << 8) | (((unsigned)(int)rintf(t[6] * sq) & 0xffu) << 16) | (((unsigned)(int)rintf(t[7] * sq) & 0xffu) << 24); }
            unsigned char* drow = b.dst + (size_t)n * b.dpitch + 32 * lane;
            *(GAS v4u*)drow = (v4u){q[0], q[1], q[2], q[3]}; *(GAS v4u*)(drow + 16) = (v4u){q[4], q[5], q[6], q[7]};
            if (lane == 0) b.sc[n] = amax * (1.0f / 127.0f); }
        LDS_WAIT(); __syncthreads();
    }
}
__device__ __forceinline__ void xconvert_range(Frame& F, const InPtrs& I, unsigned char* ws, int it0, int NIT) {
    int tid_ = threadIdx.x; asm volatile("" : "+v"(tid_));
    const int lane = tid_ & 63, wave = __builtin_amdgcn_readfirstlane(tid_ >> 6);
    LAS float* scr = (LAS float*)(F.lds + RING_OFF + wave * 16384);
    const int gw = F.vcu * NWAVES + wave, NGW = F.G * NWAVES;
    XItem xa, xb; f32x4 va[8], vb[8]; float ga[8], gb[8];
    int it = it0 + gw;
    if (it < NIT) { xdecode(xa, I, ws, it); xitem_load(xa, lane, va, ga); }
    while (it < NIT) {
        const int it1 = it + NGW;
        if (it1 < NIT) { xdecode(xb, I, ws, it1); xitem_load(xb, lane, vb, gb); }
        xitem_store(xa, lane, va, ga, scr);
        const int it2 = it1 + NGW;
        if (it1 >= NIT) break;
        if (it2 < NIT) { xdecode(xa, I, ws, it2); xitem_load(xa, lane, va, ga); }
        xitem_store(xb, lane, vb, gb, scr);
        it = it2;
    }
}
__device__ __forceinline__ void p0_prologue(Frame& F, const InPtrs& I, unsigned char* ws, u64* ss0) {
    LAS float* scr = (LAS float*)(F.lds + RING_OFF + F.wave * 16384);
    const int gw = F.vcu * NWAVES + F.wave, NGW = F.G * NWAVES, lane = F.lane;
    slab_pass(F, I, ws);
    xconvert_range(F, I, ws, 0, DEPTH * IT_LAYER);
    const size_t gt = (size_t)F.vcu * (NWAVES * 64) + F.tid, GT = (size_t)F.G * NWAVES * 64;
    for (size_t i = gt; i < (size_t)DEPTH * 8 * 128 * 128 / 8; i += GT) {
        const size_t e0 = i * 8; const int l = (int)(e0 / (8 * 128 * 128)), rem = (int)(e0 % (8 * 128 * 128)), t = (rem / 128) % 128, s0 = rem % 128;
        const f32x4 a = *(const GAS f32x4*)(I.p[10] + e0), b = *(const GAS f32x4*)(I.p[10] + e0 + 4);
        v4u o; if ((s0 >> 6) <= (t >> 6)) { o.x = pk2(a.x, a.y); o.y = pk2(a.z, a.w); o.z = pk2(b.x, b.y); o.w = pk2(b.z, b.w); } else { o = (v4u){0u, 0u, 0u, 0u}; }
        *(GAS v4u*)((bf16*)(ws + WS_W + (size_t)l * LAYER_W + OW_SGU) + rem) = o; }
    for (size_t i = gt; i < (size_t)DEPTH * M * DPLE / 8; i += GT) {
        const size_t e0 = i * 8; const int l = (int)(e0 / ((size_t)M * DPLE)); const size_t rem = e0 % ((size_t)M * DPLE); const int m = (int)(rem / DPLE), j = (int)(rem % DPLE);
        const f32x4 a = *(const GAS f32x4*)(I.p[1] + e0), b = *(const GAS f32x4*)(I.p[1] + e0 + 4);
        v4u o; o.x = pk2(a.x, a.y); o.y = pk2(a.z, a.w); o.z = pk2(b.x, b.y); o.w = pk2(b.z, b.w);
        *(GAS v4u*)((bf16*)(ws + WS_PCAT) + (size_t)m * D + l * DPLE + j) = o; }
    for (int m = gw; m < M; m += NGW) {
        const float* xr = I.p[0] + (size_t)m * D; bf16* hr = (bf16*)(ws + WS_HB2) + (size_t)m * D; unsigned char* qr = ws + WS_HB8B + (size_t)m * D; float s = 0.f; f32x4 a[4], b[4];
#pragma unroll
        for (int j = 0; j < 4; ++j) { a[j] = *(const GAS f32x4*)(xr + 512 * j + 8 * lane); b[j] = *(const GAS f32x4*)(xr + 512 * j + 8 * lane + 4);
            s += (a[j].x * a[j].x + a[j].y * a[j].y) + (a[j].z * a[j].z + a[j].w * a[j].w) + (b[j].x * b[j].x + b[j].y * b[j].y) + (b[j].z * b[j].z + b[j].w * b[j].w); }
        s = wave_sum(s); const u64 sfix = (u64)(s * SS_SCALE + 0.5f); if (lane == 0) ss0[m] = sfix;
        const float qs = (127.0f / Q_SIGMAS) * __builtin_amdgcn_rsqf(fmaf((float)(unsigned)(sfix >> 32), 4294967296.0f, (float)(unsigned)sfix) * (SS_INV / (float)D) + EPS);
#pragma unroll
        for (int j = 0; j < 4; ++j) { v4u o; o.x = pkh2(a[j].x, a[j].y); o.y = pkh2(a[j].z, a[j].w); o.z = pkh2(b[j].x, b[j].y); o.w = pkh2(b[j].z, b[j].w); *(GAS v4u*)(hr + 512 * j + 8 * lane) = o;
            unsigned q0 = 0u, q1 = 0u; const float av[4] = {a[j].x, a[j].y, a[j].z, a[j].w}, bv[4] = {b[j].x, b[j].y, b[j].z, b[j].w};
#pragma unroll
            for (int e = 0; e < 4; ++e) { q0 |= ((unsigned)(int)fminf(fmaxf(rintf(av[e] * qs), -127.0f), 127.0f) & 0xffu) << (8 * e); q1 |= ((unsigned)(int)fminf(fmaxf(rintf(bv[e] * qs), -127.0f), 127.0f) & 0xffu) << (8 * e); }
            *(GAS v2u*)(qr + 512 * j + 8 * lane) = (v2u){q0, q1}; }
    }
}

struct SchedPlain {
    pg8::TileOrder T; const char* A; const char* B; size_t astep, bstep; int nt;
    __device__ __forceinline__ bool next(int i, pg8::Unit& u) const { int pm, pn; if (!T.tile(i, pm, pn)) return false; u.pm = pm; u.pn = pn; u.kind = 0; u.keep = 0; u.A = A + (size_t)pm * astep; u.B = B + (size_t)pn * bstep; u.nt = nt; return true; }
};
struct SchedBranch {
    pg8::TileOrder T; const char* A; const char* B; size_t astep, bstep;
    __device__ __forceinline__ bool next(int i, pg8::Unit& u) const { int pm, pn; const int ti = i / 3, sub = i - 3 * ti; if (!T.tile(ti, pm, pn)) return false; u.pm = pm; u.pn = pn; u.kind = sub; u.keep = (sub != 2);
        const size_t ko = sub == 0 ? 0 : (sub == 1 ? 2048 : 3072); u.A = A + (size_t)pm * astep + ko; u.B = B + (size_t)pn * bstep + ko; u.nt = sub == 0 ? 16 : 8; return true; }
};
struct SchedPle {
    pg8::TileOrder T; const char* Ap; const char* Ah; const char* B; size_t astep, bstep;
    __device__ __forceinline__ bool next(int i, pg8::Unit& u) const { int pm, pn; const int ti = i >> 1, sub = i & 1; if (!T.tile(ti, pm, pn)) return false; u.pm = pm; u.pn = pn; u.kind = sub; u.keep = 0;
        u.A = (sub == 0 ? Ap : Ah) + (size_t)pm * astep; u.B = B + (size_t)pn * bstep + (sub == 0 ? (size_t)D * 2 : 0); u.nt = sub == 0 ? DPLE / 64 : D / 64; return true; }
};

constexpr int GATE_BYTE0 = 4096 * 2;
typedef pg8::f32x4 A4;
__device__ __forceinline__ v4u pack8(const A4& a, const A4& b) { v4u w; w.x = pg8::cvt_pk_bf16(a[0], a[1]); w.y = pg8::cvt_pk_bf16(a[2], a[3]); w.z = pg8::cvt_pk_bf16(b[0], b[1]); w.w = pg8::cvt_pk_bf16(b[2], b[3]); return w; }
__device__ __forceinline__ v4u packh8(const A4& a, const A4& b) { v4u w; w.x = pkh2(a[0], a[1]); w.y = pkh2(a[2], a[3]); w.z = pkh2(b[0], b[1]); w.w = pkh2(b[2], b[3]); return w; }
__device__ __forceinline__ float dot2sq(const unsigned w, const float c) { const h16x2 h = __builtin_bit_cast(h16x2, w); return __builtin_amdgcn_fdot2(h, h, c, false); }
__device__ __forceinline__ float sumsqh8(const v4u w) { return dot2sq(w.w, dot2sq(w.z, dot2sq(w.y, dot2sq(w.x, 0.0f)))); }
__device__ __forceinline__ v2u ss_raw(const u64* ss, int row) { return *(const GAS v2u*)(ss + row); }
__device__ __forceinline__ float ss_cvt(const v2u w) { return fmaf((float)w.y, 4294967296.0f, (float)w.x) * (SS_INV / (float)D) + EPS; }
__device__ __forceinline__ float rinv_c(const v2u w) { return __builtin_amdgcn_rsqf(ss_cvt(w)); }
__device__ __forceinline__ float rms_c(const v2u w) { const float x = ss_cvt(w); return x * __builtin_amdgcn_rsqf(x); }
__device__ __forceinline__ float ssf(const u64* ss, int row) { const v2u w = *(const GAS v2u*)(ss + row); return fmaf((float)w.y, 4294967296.0f, (float)w.x); }
__device__ __forceinline__ float rinv_of(const u64* ss, int row) { return __builtin_amdgcn_rsqf(ssf(ss, row) * (SS_INV / (float)D) + EPS); }
__device__ __forceinline__ float rms_of(const u64* ss, int row) { const float x = ssf(ss, row) * (SS_INV / (float)D) + EPS; return x * __builtin_amdgcn_rsqf(x); }
__device__ __forceinline__ void ss_add(u64* ss, int row, float q) { (void)__hip_atomic_fetch_add((GAS u64*)(ss + row), (u64)(q * SS_SCALE + 0.5f), __ATOMIC_RELAXED, __HIP_MEMORY_SCOPE_AGENT); }

struct EpiSwiglu {
    bf16* hid; const u64* ss;
    __device__ __forceinline__ void operator()(A4 (&acc)[2][2][4][2], const pg8::Unit& u, int wr, int wc, int fr, int fq) const {
        const int row0 = u.pm * 256 + wr * 64 + fr, col0 = u.pn * 128 + wc * 32 + 8 * fq;
        v2u ra[2][4]; float rv[2][4];
#pragma unroll
        for (int ai = 0; ai < 2; ++ai)
#pragma unroll
            for (int m = 0; m < 4; ++m) ra[ai][m] = ss_raw(ss, row0 + ai * 128 + m * 16);
#pragma unroll
        for (int ai = 0; ai < 2; ++ai)
#pragma unroll
            for (int m = 0; m < 4; ++m) rv[ai][m] = rinv_c(ra[ai][m]);
#pragma unroll
        for (int ai = 0; ai < 2; ++ai)
#pragma unroll
            for (int m = 0; m < 4; ++m) { const int row = row0 + ai * 128 + m * 16; const float ri = rv[ai][m];
                A4 o[2];
#pragma unroll
                for (int n = 0; n < 2; ++n) { const A4 g = acc[ai][0][m][n] * ri, up = acc[ai][1][m][n] * ri;
#pragma unroll
                    for (int j = 0; j < 4; ++j) o[n][j] = g[j] * fast_sigmoid(g[j]) * up[j]; }
                *(GAS v4u*)(hid + (size_t)row * FFP + col0) = pack8(o[0], o[1]); }
    }
};
__device__ __forceinline__ float sumsq8(const v4u w) { const float a = bflo(w.x), b = bfhi(w.x), c = bflo(w.y), d = bfhi(w.y), e = bflo(w.z), f = bfhi(w.z), g = bflo(w.w), h = bfhi(w.w);
    return ((a * a + b * b) + (c * c + d * d)) + ((e * e + f * f) + (g * g + h * h)); }
__device__ __forceinline__ unsigned q8x4(const A4 v, float qs) {
    const float MAG = 12582912.0f;
    const f32x2 a = (f32x2){v[0], v[1]} * qs + MAG, b = (f32x2){v[2], v[3]} * qs + MAG;
    const unsigned x0 = __builtin_bit_cast(unsigned, __builtin_amdgcn_fmed3f(a.x, MAG - 127.0f, MAG + 127.0f)), x1 = __builtin_bit_cast(unsigned, __builtin_amdgcn_fmed3f(a.y, MAG - 127.0f, MAG + 127.0f));
    const unsigned x2 = __builtin_bit_cast(unsigned, __builtin_amdgcn_fmed3f(b.x, MAG - 127.0f, MAG + 127.0f)), x3 = __builtin_bit_cast(unsigned, __builtin_amdgcn_fmed3f(b.y, MAG - 127.0f, MAG + 127.0f));
    return __builtin_amdgcn_perm(__builtin_amdgcn_perm(x3, x2, 0x0c0c0400u), __builtin_amdgcn_perm(x1, x0, 0x0c0c0400u), 0x05040100u); }
struct EpiResid {
    const bf16* hin; bf16* hout; u64* ssout; unsigned char* h8; const u64* ssq; unsigned char* hbf; float scale;
    __device__ __forceinline__ void operator()(A4 (&acc)[2][2][4][2], const pg8::Unit& u, int wr, int wc, int fr, int fq) const {
        const int row0 = u.pm * 256 + wr * 64 + fr, col0 = u.pn * 256 + wc * 32 + 8 * fq;
        v4u o[4][2][2]; v2u rq[4][2];
#define RESID_LOAD(g) do { _Pragma("unroll") for (int mm = 0; mm < 2; ++mm) { const int row = row0 + ((g) >> 1) * 128 + (2 * ((g) & 1) + mm) * 16; \
            _Pragma("unroll") for (int bj = 0; bj < 2; ++bj) o[g][mm][bj] = *(const GAS v4u*)(hin + (size_t)row * D + col0 + bj * 128); \
            rq[g][mm] = h8 ? ss_raw(ssq, row) : (v2u){0u, 0u}; } } while (0)
#define RESID_COMP(g) do { _Pragma("unroll") for (int mm = 0; mm < 2; ++mm) { const int ai = (g) >> 1, m = 2 * ((g) & 1) + mm, row = row0 + ai * 128 + m * 16; float q = 0.f; const float qs = h8 ? rinv_c(rq[g][mm]) * (127.0f / Q_SIGMAS) : 0.f; \
            _Pragma("unroll") for (int bj = 0; bj < 2; ++bj) { const v4u ov = o[g][mm][bj]; const A4 a0 = acc[ai][bj][m][0], a1 = acc[ai][bj][m][1]; \
                const A4 v0 = {__builtin_fmaf(a0[0], scale, hlo(ov.x)), __builtin_fmaf(a0[1], scale, hhi(ov.x)), __builtin_fmaf(a0[2], scale, hlo(ov.y)), __builtin_fmaf(a0[3], scale, hhi(ov.y))}; \
                const A4 v1 = {__builtin_fmaf(a1[0], scale, hlo(ov.z)), __builtin_fmaf(a1[1], scale, hhi(ov.z)), __builtin_fmaf(a1[2], scale, hlo(ov.w)), __builtin_fmaf(a1[3], scale, hhi(ov.w))}; \
                const v4u w = packh8(v0, v1); *(GAS v4u*)(hout + (size_t)row * D + col0 + bj * 128) = w; q += sumsqh8(w); \
                if (h8) *(GAS v2u*)(h8 + (size_t)row * D + col0 + bj * 128) = (v2u){q8x4(v0, qs), q8x4(v1, qs)}; \
                if (hbf) *(GAS v4u*)(hbf + ((size_t)row * D + col0 + bj * 128) * 2) = pack8(v0, v1); } \
            q += __shfl_xor(q, 16); q += __shfl_xor(q, 32); \
            if (fq == 0) ss_add(ssout, row, q); } } while (0)
        RESID_LOAD(0); RESID_LOAD(1); RESID_COMP(0); RESID_LOAD(2); RESID_COMP(1); RESID_LOAD(3); RESID_COMP(2); RESID_COMP(3);
#undef RESID_LOAD
#undef RESID_COMP
    }
};
struct EpiWin {
    bf16* z; const u64* ss; LAS unsigned char* area; int pn0;
    __device__ __forceinline__ void prefetch(const pg8::Unit& u, int tid, int wave) const { asm volatile("" : "+v"(tid));
        __builtin_amdgcn_global_load_lds((const unsigned*)(ss + (size_t)u.pm * 256) + tid, (LAS unsigned*)(area + u.par * EPI_AREA_BYTES + wave * 256), 4, 0, 0); }
    __device__ __forceinline__ void operator()(A4 (&acc)[2][2][4][2], const pg8::Unit& u, int wr, int wc, int fr, int fq) const {
        const int pnz = u.pn + pn0; const int row0 = u.pm * 256 + wr * 64 + fr, col0 = pnz * 256 + wc * 32 + 8 * fq; const int act = pnz < 8 ? 1 : 0;
        v2u ra[2][4]; float rv[2][4];
#pragma unroll
        for (int ai = 0; ai < 2; ++ai)
#pragma unroll
            for (int m = 0; m < 4; ++m) ra[ai][m] = *(const LAS v2u*)(area + u.par * EPI_AREA_BYTES + (wr * 64 + fr + ai * 128 + m * 16) * 8);
#pragma unroll
        for (int ai = 0; ai < 2; ++ai)
#pragma unroll
            for (int m = 0; m < 4; ++m) rv[ai][m] = rinv_c(ra[ai][m]);
        if (act == 1) {
#pragma unroll
            for (int ai = 0; ai < 2; ++ai)
#pragma unroll
                for (int m = 0; m < 4; ++m) { const int row = row0 + ai * 128 + m * 16; const float ri = rv[ai][m];
#pragma unroll
                    for (int bj = 0; bj < 2; ++bj) { const A4 v0 = acc[ai][bj][m][0] * ri, v1 = acc[ai][bj][m][1] * ri;
                        f32x2 g[4] = {{v0[0], v0[1]}, {v0[2], v0[3]}, {v1[0], v1[1]}, {v1[2], v1[3]}}; pg8::gelu_pk4(g);
                        *(GAS v4u*)(z + (size_t)row * ZP + col0 + bj * 128) = pack8((A4){g[0].x, g[0].y, g[1].x, g[1].y}, (A4){g[2].x, g[2].y, g[3].x, g[3].y}); } }
        } else {
#pragma unroll
            for (int ai = 0; ai < 2; ++ai)
#pragma unroll
                for (int m = 0; m < 4; ++m) { const int row = row0 + ai * 128 + m * 16; const float ri = rv[ai][m];
#pragma unroll
                    for (int bj = 0; bj < 2; ++bj) *(GAS v4u*)(z + (size_t)row * ZP + col0 + bj * 128) = pack8(acc[ai][bj][m][0] * ri, acc[ai][bj][m][1] * ri); }
        }
    }
};
namespace pg8 { template <> struct EpiPrefetch<EpiWin> { static constexpr bool on = true; }; }
typedef pg8::i32x4 I4;
struct EpiGate8 {
    unsigned char* ws; LAS unsigned char* area; unsigned ssoff, wsoff;
    __device__ __forceinline__ void prefetch(const pg8::Unit& u, int tid, int wave) const { asm volatile("" : "+v"(tid));
        LAS unsigned char* base = area + u.par * EPI_AREA_BYTES + wave * 256;
        __builtin_amdgcn_global_load_lds((const unsigned*)(ws + ssoff + (size_t)u.pm * 2048) + tid, (LAS unsigned*)base, 4, 0, 0);
        if (wave < 4) { __builtin_amdgcn_global_load_lds((const unsigned*)(ws + WS_SC + (size_t)u.pm * 1024) + tid, (LAS unsigned*)(base + 2048), 4, 0, 0);
                        __builtin_amdgcn_global_load_lds((const unsigned*)(ws + wsoff + (size_t)u.pn * 1024) + tid, (LAS unsigned*)(base + 4096), 4, 0, 0); }
    }
    __device__ __forceinline__ void operator()(I4 (&acc)[2][2][4][2], const pg8::Unit& u, int wr, int wc, int fr, int fq) const {
        const int row0 = u.pm * 256 + wr * 64 + fr, col0 = u.pn * 256 + wc * 32 + 8 * fq;
        const LAS unsigned char* la = area + u.par * EPI_AREA_BYTES; const LAS float* lw = (const LAS float*)(la + 4096) + wc * 32 + 8 * fq;
        float rv[2][4];
#pragma unroll
        for (int ai = 0; ai < 2; ++ai)
#pragma unroll
            for (int m = 0; m < 4; ++m) { const int lr = wr * 64 + fr + ai * 128 + m * 16; rv[ai][m] = rinv_c(*(const LAS v2u*)(la + lr * 8)) * *(const LAS float*)(la + 2048 + lr * 4); }
#pragma unroll
        for (int bj = 0; bj < 2; ++bj) { const f32x4 w0 = *(const LAS f32x4*)(lw + bj * 128) * -1.44269504089f, w1 = *(const LAS f32x4*)(lw + bj * 128 + 4) * -1.44269504089f;
            const f32x2 wn[4] = {{w0[0], w0[1]}, {w0[2], w0[3]}, {w1[0], w1[1]}, {w1[2], w1[3]}};
#pragma unroll
            for (int ai = 0; ai < 2; ++ai)
#pragma unroll
                for (int m = 0; m < 4; ++m) { const int row = row0 + ai * 128 + m * 16; const float ri = rv[ai][m]; unsigned x[8];
                    f32x2 t2[4], d2[4], r2[4], w2[4];
#pragma unroll
                    for (int p = 0; p < 4; ++p) { const I4 av = acc[ai][bj][m][p >> 1]; const int j = 2 * (p & 1); const f32x2 a2 = {(float)av[j], (float)av[j + 1]}; t2[p] = a2 * (wn[p] * ri); }
#pragma unroll
                    for (int p = 0; p < 4; ++p) d2[p] = (f32x2){__builtin_amdgcn_exp2f(t2[p].x), __builtin_amdgcn_exp2f(t2[p].y)} + 1.0f;
#pragma unroll
                    for (int p = 0; p < 4; ++p) r2[p] = (f32x2){__builtin_amdgcn_rcpf(d2[p].x), __builtin_amdgcn_rcpf(d2[p].y)};
#pragma unroll
                    for (int p = 0; p < 4; ++p) w2[p] = r2[p] * 255.0f + 8388608.0f;
#pragma unroll
                    for (int p = 0; p < 4; ++p) { x[2 * p] = __builtin_bit_cast(unsigned, fmaxf(w2[p].x, 8388609.0f)); x[2 * p + 1] = __builtin_bit_cast(unsigned, fmaxf(w2[p].y, 8388609.0f)); }
                    const unsigned q0 = __builtin_amdgcn_perm(__builtin_amdgcn_perm(x[3], x[2], 0x0c0c0400u), __builtin_amdgcn_perm(x[1], x[0], 0x0c0c0400u), 0x05040100u);
                    const unsigned q1 = __builtin_amdgcn_perm(__builtin_amdgcn_perm(x[7], x[6], 0x0c0c0400u), __builtin_amdgcn_perm(x[5], x[4], 0x0c0c0400u), 0x05040100u);
                    *(GAS v2u*)(ws + WS_ZH + (size_t)row * (ZP * 2) + GATE_BYTE0 + col0 + bj * 128) = (v2u){q0, q1}; } }
    }
};
namespace pg8 { template <> struct EpiPrefetch<EpiGate8> { static constexpr bool on = true; }; }
__device__ __forceinline__ void u8x8_to_f(const v2u w, float (&f)[8]) {
    f[0] = (float)(w.x & 0xffu); f[1] = (float)((w.x >> 8) & 0xffu); f[2] = (float)((w.x >> 16) & 0xffu); f[3] = (float)(w.x >> 24);
    f[4] = (float)(w.y & 0xffu); f[5] = (float)((w.y >> 8) & 0xffu); f[6] = (float)((w.y >> 16) & 0xffu); f[7] = (float)(w.y >> 24); }
struct EpiBranch {
    const bf16* z; bf16* mb;
    __device__ __forceinline__ void operator()(A4 (&acc)[2][2][4][2], const pg8::Unit& u, int wr, int wc, int fr, int fq) const {
        const int row0 = u.pm * 256 + wr * 64 + fr, col0 = u.pn * 256 + wc * 32 + 8 * fq; const int kind = u.kind;
        const unsigned char* gbase = (const unsigned char*)z + GATE_BYTE0 + col0;
        v2u ga[4][2][2], gb[4][2][2];
#define BR_LOAD(g) do { _Pragma("unroll") for (int mm = 0; mm < 2; ++mm) _Pragma("unroll") for (int bj = 0; bj < 2; ++bj) { \
            const unsigned char* gp = gbase + (size_t)(row0 + ((g) >> 1) * 128 + (2 * ((g) & 1) + mm) * 16) * (ZP * 2) + bj * 128; \
            ga[g][mm][bj] = *(const GAS v2u*)(gp + kind * 2048); gb[g][mm][bj] = (kind != 2) ? *(const GAS v2u*)(gp + (kind + 1) * 2048) : (v2u){0u, 0u}; } } while (0)
#define BR_COMP(g) do { _Pragma("unroll") for (int mm = 0; mm < 2; ++mm) _Pragma("unroll") for (int bj = 0; bj < 2; ++bj) { const int ai = (g) >> 1, m = 2 * ((g) & 1) + mm; float a[8], b[8]; u8x8_to_f(ga[g][mm][bj], a); \
            if (kind != 2) { u8x8_to_f(gb[g][mm][bj], b); _Pragma("unroll") for (int j = 0; j < 8; ++j) a[j] *= __builtin_amdgcn_rcpf(b[j]); } \
            else { _Pragma("unroll") for (int j = 0; j < 8; ++j) a[j] *= (1.0f / 255.0f); } \
            acc[ai][bj][m][0] *= (A4){a[0], a[1], a[2], a[3]}; acc[ai][bj][m][1] *= (A4){a[4], a[5], a[6], a[7]}; \
            if (kind == 2) *(GAS v4u*)(mb + (size_t)(row0 + ai * 128 + m * 16) * D + col0 + bj * 128) = pack8(acc[ai][bj][m][0], acc[ai][bj][m][1]); } } while (0)
        BR_LOAD(0); BR_LOAD(1); BR_COMP(0); BR_LOAD(2); BR_COMP(1); BR_LOAD(3); BR_COMP(2); BR_COMP(3);
#undef BR_LOAD
#undef BR_COMP
    }
};
struct EpiPle {
    const bf16* hin; bf16* hout; bf16* tmp; const u64* ss; u64* ssout;
    __device__ __forceinline__ void operator()(A4 (&acc)[2][2][4][2], const pg8::Unit& u, int wr, int wc, int fr, int fq) const {
        const int row0 = u.pm * 256 + wr * 64 + fr, col0 = u.pn * 256 + wc * 32 + 8 * fq; const int kind = u.kind;
        if (kind == 0) {
#pragma unroll
            for (int ai = 0; ai < 2; ++ai)
#pragma unroll
                for (int m = 0; m < 4; ++m)
#pragma unroll
                    for (int bj = 0; bj < 2; ++bj) *(GAS v4u*)(tmp + (size_t)(row0 + ai * 128 + m * 16) * D + col0 + bj * 128) = pack8(acc[ai][bj][m][0], acc[ai][bj][m][1]);
        } else {
#pragma unroll
            for (int ai = 0; ai < 2; ++ai)
#pragma unroll
            for (int mh = 0; mh < 2; ++mh) {
                v4u o[2][2], t[2][2]; float ri[2];
#pragma unroll
                for (int mm = 0; mm < 2; ++mm) { const int row = row0 + ai * 128 + (2 * mh + mm) * 16; ri[mm] = rinv_of(ss, row);
#pragma unroll
                    for (int bj = 0; bj < 2; ++bj) { const size_t off = (size_t)row * D + col0 + bj * 128; o[mm][bj] = *(const GAS v4u*)(hin + off); t[mm][bj] = *(const GAS v4u*)(tmp + off); } }
#pragma unroll
                for (int mm = 0; mm < 2; ++mm) { const int m = 2 * mh + mm, row = row0 + ai * 128 + m * 16; float q = 0.f;
#pragma unroll
                    for (int bj = 0; bj < 2; ++bj) { const v4u ov = o[mm][bj], tv = t[mm][bj];
                        A4 g0 = acc[ai][bj][m][0] * ri[mm], g1 = acc[ai][bj][m][1] * ri[mm];
#pragma unroll
                        for (int j = 0; j < 4; ++j) { g0[j] = fast_sigmoid(g0[j]); g1[j] = fast_sigmoid(g1[j]); }
                        const A4 v0 = (A4){bflo(ov.x), bfhi(ov.x), bflo(ov.y), bfhi(ov.y)} + g0 * (A4){bflo(tv.x), bfhi(tv.x), bflo(tv.y), bfhi(tv.y)}, v1 = (A4){bflo(ov.z), bfhi(ov.z), bflo(ov.w), bfhi(ov.w)} + g1 * (A4){bflo(tv.z), bfhi(tv.z), bflo(tv.w), bfhi(tv.w)};
                        const v4u w = pack8(v0, v1); *(GAS v4u*)(hout + (size_t)row * D + col0 + bj * 128) = w; q += sumsq8(w); }
                    q += __shfl_xor(q, 16); q += __shfl_xor(q, 32);
                    if (fq == 0) ss_add(ssout, row, q); }
            }
        }
    }
};

struct EpiSwiglu8 {
    bf16* hid; const u64* ss; const u64* ssq; const float* wscale; LAS unsigned char* area;
    __device__ __forceinline__ void prefetch(const pg8::Unit& u, int tid, int wave) const { asm volatile("" : "+v"(tid));

        LAS unsigned char* base = area + u.par * EPI_AREA_BYTES + wave * 256;
        __builtin_amdgcn_global_load_lds((const unsigned*)(ss + (size_t)u.pm * 256) + tid, (LAS unsigned*)base, 4, 0, 0);
        __builtin_amdgcn_global_load_lds((const unsigned*)(ssq + (size_t)u.pm * 256) + tid, (LAS unsigned*)(base + 2048), 4, 0, 0);
        if (wave < 4) __builtin_amdgcn_global_load_lds((const unsigned*)(wscale + (size_t)u.pn * 256) + tid, (LAS unsigned*)(base + 4096), 4, 0, 0);
    }
    __device__ __forceinline__ void operator()(I4 (&acc)[2][2][4][2], const pg8::Unit& u, int wr, int wc, int fr, int fq) const {
        const int row0 = u.pm * 256 + wr * 64 + fr, col0 = u.pn * 128 + wc * 32 + 8 * fq, wrow0 = u.pn * 256 + wc * 32 + 8 * fq;
        bf16* const hblk = hid + ((size_t)(u.pm * (FF / 64) + u.pn * 2 + (wc >> 1)) * 256 + wr * 64 + fr) * 64 + (wc & 1) * 32 + 8 * fq;
        const LAS unsigned char* la = area + u.par * EPI_AREA_BYTES; const LAS float* lw = (const LAS float*)(la + 4096) + wc * 32 + 8 * fq;
        const f32x4 g0w = *(const LAS f32x4*)lw, g1w = *(const LAS f32x4*)(lw + 4), u0w = *(const LAS f32x4*)(lw + 128), u1w = *(const LAS f32x4*)(lw + 132);
        v2u ra[2][4], rb[2][4]; float rv[2][4];
#pragma unroll
        for (int ai = 0; ai < 2; ++ai)
#pragma unroll
            for (int m = 0; m < 4; ++m) { const int lr = (wr * 64 + fr + ai * 128 + m * 16) * 8; ra[ai][m] = *(const LAS v2u*)(la + lr); rb[ai][m] = *(const LAS v2u*)(la + 2048 + lr); }
#pragma unroll
        for (int ai = 0; ai < 2; ++ai)
#pragma unroll
            for (int m = 0; m < 4; ++m) rv[ai][m] = rinv_c(ra[ai][m]) * (Q_SIGMAS / 127.0f) * rms_c(rb[ai][m]);
        f32x2 gn[4], gu[4];
#pragma unroll
        for (int q = 0; q < 2; ++q) { const f32x4 gw = q ? g1w : g0w, uw = q ? u1w : u0w;
            gn[2 * q] = (f32x2){gw[0], gw[1]} * -1.44269504089f; gn[2 * q + 1] = (f32x2){gw[2], gw[3]} * -1.44269504089f;
            gu[2 * q] = (f32x2){gw[0], gw[1]} * (f32x2){uw[0], uw[1]}; gu[2 * q + 1] = (f32x2){gw[2], gw[3]} * (f32x2){uw[2], uw[3]}; }
#pragma unroll
        for (int ai = 0; ai < 2; ++ai)
#pragma unroll
            for (int m = 0; m < 4; ++m) { const float ri = rv[ai][m], ri2 = ri * ri; f32x2 o[4];
#pragma unroll
                for (int p = 0; p < 4; ++p) { const I4 ag = acc[ai][0][m][p >> 1], au = acc[ai][1][m][p >> 1]; const int j = 2 * (p & 1);
                    const f32x2 a2 = {(float)ag[j], (float)ag[j + 1]}, b2 = {(float)au[j], (float)au[j + 1]};
                    const f32x2 t2 = a2 * (gn[p] * ri);
                    const f32x2 d2 = (f32x2){__builtin_amdgcn_exp2f(t2.x), __builtin_amdgcn_exp2f(t2.y)} + 1.0f;
                    const f32x2 r2 = {__builtin_amdgcn_rcpf(d2.x), __builtin_amdgcn_rcpf(d2.y)};
                    o[p] = ((a2 * b2) * (gu[p] * ri2)) * r2; }
                v4u w; w.x = pg8::cvt_pk_bf16(o[0].x, o[0].y); w.y = pg8::cvt_pk_bf16(o[1].x, o[1].y); w.z = pg8::cvt_pk_bf16(o[2].x, o[2].y); w.w = pg8::cvt_pk_bf16(o[3].x, o[3].y);
                *(GAS v4u*)(hblk + (size_t)(ai * 128 + m * 16) * 64) = w; }
    }
};
namespace pg8 { template <> struct EpiPrefetch<EpiSwiglu8> { static constexpr bool on = true; }; }
struct EpiProj {
    bf16* tmp;
    __device__ __forceinline__ void operator()(A4 (&acc)[2][2][4][2], const pg8::Unit& u, int wr, int wc, int fr, int fq) const {
        const int row0 = u.pm * 256 + wr * 64 + fr, col0 = u.pn * 256 + wc * 32 + 8 * fq;
#pragma unroll
        for (int ai = 0; ai < 2; ++ai)
#pragma unroll
            for (int m = 0; m < 4; ++m)
#pragma unroll
                for (int bj = 0; bj < 2; ++bj) *(GAS v4u*)(tmp + (size_t)(row0 + ai * 128 + m * 16) * D + col0 + bj * 128) = pack8(acc[ai][bj][m][0], acc[ai][bj][m][1]);
    }
};
struct EpiPleGate8 {
    const bf16* hin; bf16* hout; const bf16* tmp; const u64* ss; const u64* ssq; const float* wscale; u64* ssout; unsigned char* h8; LAS unsigned char* area;
    __device__ __forceinline__ void prefetch(const pg8::Unit& u, int tid, int wave) const { asm volatile("" : "+v"(tid));
        LAS unsigned char* base = area + u.par * EPI_AREA_BYTES + wave * 256;
        __builtin_amdgcn_global_load_lds((const unsigned*)(ss + (size_t)u.pm * 256) + tid, (LAS unsigned*)base, 4, 0, 0);
        __builtin_amdgcn_global_load_lds((const unsigned*)(ssq + (size_t)u.pm * 256) + tid, (LAS unsigned*)(base + 2048), 4, 0, 0);
        if (wave < 4) __builtin_amdgcn_global_load_lds((const unsigned*)(wscale + (size_t)u.pn * 256) + tid, (LAS unsigned*)(base + 4096), 4, 0, 0);
    }
    __device__ __forceinline__ void operator()(I4 (&acc)[2][2][4][2], const pg8::Unit& u, int wr, int wc, int fr, int fq) const {
        const int row0 = u.pm * 256 + wr * 64 + fr, col0 = u.pn * 256 + wc * 32 + 8 * fq;
        const LAS unsigned char* la = area + u.par * EPI_AREA_BYTES; const LAS float* lw = (const LAS float*)(la + 4096) + wc * 32 + 8 * fq;
#pragma unroll
        for (int ai = 0; ai < 2; ++ai) {
            v2u ra[4], rb[4]; float rv[4], qq[4], qsv[4];
#pragma unroll
            for (int m = 0; m < 4; ++m) { const int lr = (wr * 64 + fr + ai * 128 + m * 16) * 8; ra[m] = *(const LAS v2u*)(la + lr); rb[m] = *(const LAS v2u*)(la + 2048 + lr); }
#pragma unroll
            for (int m = 0; m < 4; ++m) { const float r3 = rinv_c(ra[m]); rv[m] = r3 * (Q_SIGMAS / 127.0f) * rms_c(rb[m]); qq[m] = 0.f; qsv[m] = r3 * (127.0f / Q_SIGMAS); }
#pragma unroll
            for (int bj = 0; bj < 2; ++bj) { const f32x4 w0 = *(const LAS f32x4*)(lw + bj * 128), w1 = *(const LAS f32x4*)(lw + bj * 128 + 4);
                v4u o[4], t[4];
#pragma unroll
                for (int m = 0; m < 4; ++m) { const size_t off = (size_t)(row0 + ai * 128 + m * 16) * D + col0 + bj * 128; o[m] = *(const GAS v4u*)(hin + off); t[m] = *(const GAS v4u*)(tmp + off); }
#pragma unroll
                for (int m = 0; m < 4; ++m) { const int row = row0 + ai * 128 + m * 16; const float ri = rv[m]; const v4u ov = o[m], tv = t[m]; A4 g0, g1;
#pragma unroll
                    for (int j = 0; j < 4; ++j) { g0[j] = fast_sigmoid((float)acc[ai][bj][m][0][j] * ri * w0[j]); g1[j] = fast_sigmoid((float)acc[ai][bj][m][1][j] * ri * w1[j]); }
                    const A4 v0 = (A4){hlo(ov.x), hhi(ov.x), hlo(ov.y), hhi(ov.y)} + g0 * (A4){bflo(tv.x), bfhi(tv.x), bflo(tv.y), bfhi(tv.y)}, v1 = (A4){hlo(ov.z), hhi(ov.z), hlo(ov.w), hhi(ov.w)} + g1 * (A4){bflo(tv.z), bfhi(tv.z), bflo(tv.w), bfhi(tv.w)};
                    const v4u w = packh8(v0, v1); *(GAS v4u*)(hout + (size_t)row * D + col0 + bj * 128) = w; qq[m] += sumsqh8(w);
                    *(GAS v2u*)(h8 + (size_t)row * D + col0 + bj * 128) = (v2u){q8x4(v0, qsv[m]), q8x4(v1, qsv[m])}; } }
#pragma unroll
            for (int m = 0; m < 4; ++m) { float q = qq[m]; q += __shfl_xor(q, 16); q += __shfl_xor(q, 32); if (fq == 0) ss_add(ssout, row0 + ai * 128 + m * 16, q); }
        }
    }
};
namespace pg8 { template <> struct EpiPrefetch<EpiPleGate8> { static constexpr bool on = true; }; }
constexpr int TP = 136;
__device__ __forceinline__ void unpack8(const v4u w, float (&f)[8]) { f[0] = bflo(w.x); f[1] = bfhi(w.x); f[2] = bflo(w.y); f[3] = bfhi(w.y); f[4] = bflo(w.z); f[5] = bfhi(w.z); f[6] = bflo(w.w); f[7] = bfhi(w.w); }
template <bool SRC_F16>
__device__ __forceinline__ void quant_row(const bf16* srow, unsigned char* drow, float* sc, int lane) {
    v4u w[4]; float f[32];
#pragma unroll
    for (int j = 0; j < 4; ++j) w[j] = *(const GAS v4u*)(srow + 32 * lane + 8 * j);
    float amax = 0.f;
#pragma unroll
    for (int j = 0; j < 4; ++j) { float t[8];
        if (SRC_F16) { t[0] = hlo(w[j].x); t[1] = hhi(w[j].x); t[2] = hlo(w[j].y); t[3] = hhi(w[j].y); t[4] = hlo(w[j].z); t[5] = hhi(w[j].z); t[6] = hlo(w[j].w); t[7] = hhi(w[j].w); } else unpack8(w[j], t);
#pragma unroll
        for (int e = 0; e < 8; ++e) { f[8 * j + e] = t[e]; amax = fmaxf(amax, fabsf(t[e])); } }
#pragma unroll
    for (int o = 1; o < 64; o <<= 1) amax = fmaxf(amax, __shfl_xor(amax, o));
    const float s = amax > 0.f ? 127.0f / amax : 0.f;
    v4u o0, o1; unsigned q[8];
#pragma unroll
    for (int j = 0; j < 8; ++j) { const int a = (int)rintf(f[4 * j] * s), b = (int)rintf(f[4 * j + 1] * s), c = (int)rintf(f[4 * j + 2] * s), d = (int)rintf(f[4 * j + 3] * s);
        q[j] = ((unsigned)a & 0xffu) | (((unsigned)b & 0xffu) << 8) | (((unsigned)c & 0xffu) << 16) | (((unsigned)d & 0xffu) << 24); }
    o0 = (v4u){q[0], q[1], q[2], q[3]}; o1 = (v4u){q[4], q[5], q[6], q[7]};
    *(GAS v4u*)(drow + 32 * lane) = o0; *(GAS v4u*)(drow + 32 * lane + 16) = o1;
    if (lane == 0) *sc = amax * (1.0f / 127.0f);
}
__device__ __forceinline__ void quant_h_phase(Frame& F, const bf16* __restrict__ h, unsigned char* __restrict__ h8, float* __restrict__ ascale) {
    int tid_ = threadIdx.x; asm volatile("" : "+v"(tid_));
    const int lane = tid_ & 63, wave = __builtin_amdgcn_readfirstlane(tid_ >> 6);
    if (F.G == 256) { const int base = (F.vcu >> 5) * 2048 + (F.vcu & 31) * NWAVES + wave;
        for (int jj = 0; jj < 8; ++jj) { const int m = base + 256 * jj; quant_row<true>(h + (size_t)m * D, h8 + (size_t)m * D, ascale + m, lane); }
    } else { const int gw = F.vcu * NWAVES + wave, NGW = F.G * NWAVES; for (int m = gw; m < M; m += NGW) quant_row<true>(h + (size_t)m * D, h8 + (size_t)m * D, ascale + m, lane); }
}
__device__ __forceinline__ void mixer_phase(Frame& F, const bf16* __restrict__ z, bf16* __restrict__ ycat, const float* __restrict__ ng, const float* __restrict__ nbias, const bf16* __restrict__ sguw,
                                            const float* __restrict__ sgub, const float* __restrict__ convw, const bf16* __restrict__ poolwt, const float* __restrict__ pscale) {
    LAS f32x2* stats = (LAS f32x2*)(F.lds + RING_OFF);
    LAS bf16* tile0 = (LAS bf16*)(F.lds + RING_OFF + 1024);
    constexpr int TILE_ELEMS = 128 * TP + 64;
    int tid_ = threadIdx.x; asm volatile("" : "+v"(tid_));
    const int tid = tid_, lane = tid & 63, wave = __builtin_amdgcn_readfirstlane(tid >> 6), fr = lane & 15, fq = lane >> 4;
    for (int un = F.vcu; un < 2 * (M / 128); un += F.G) {
        const int nbk = un >> 1, half = un & 1, row0 = nbk * 128;
        for (int tb = 0; tb < 4; ++tb) { v4u ra[4], rb[4];
#pragma unroll
            for (int tt = 0; tt < 4; ++tt) { const bf16* vp = z + (size_t)(row0 + 16 * wave + 4 * tb + tt) * ZP + 1024 + 16 * lane; ra[tt] = *(const GAS v4u*)vp; rb[tt] = *(const GAS v4u*)(vp + 8); }
#pragma unroll
            for (int tt = 0; tt < 4; ++tt) { float f[16];
                { float g[8]; unpack8(ra[tt], g);
#pragma unroll
                  for (int j = 0; j < 8; ++j) f[j] = g[j];
                  unpack8(rb[tt], g);
#pragma unroll
                  for (int j = 0; j < 8; ++j) f[8 + j] = g[j]; }
                float s = 0.f;
#pragma unroll
                for (int j = 0; j < 16; ++j) s += f[j];
                const float mean = wave_sum(s) * (1.0f / 1024.0f); float q = 0.f;
#pragma unroll
                for (int j = 0; j < 16; ++j) { const float d = f[j] - mean; q += d * d; }
                const float rstd = 1.0f / sqrtf(wave_sum(q) * (1.0f / 1024.0f) + EPS);
                if (lane == 0) stats[16 * wave + 4 * tb + tt] = (f32x2){mean, rstd}; } }
        const int srow = tid >> 2, cq = tid & 3;
        v4u raw[4];
#pragma unroll
        for (int q = 0; q < 4; ++q) raw[q] = *(const GAS v4u*)(z + (size_t)(row0 + srow) * ZP + 1024 + (half * 4) * 128 + 8 * cq + 32 * q);
        LDS_WAIT(); __syncthreads();
        const f32x2 st = stats[srow];
        for (int gi = 0; gi < 4; ++gi) { const int g = half * 4 + gi; LAS bf16* tile = tile0 + (gi & 1) * TILE_ELEMS;
            f32x4 lg[4][2], lb[4][2];
#pragma unroll
            for (int q = 0; q < 4; ++q) { const int ch = g * 128 + 8 * cq + 32 * q; lg[q][0] = *(const GAS f32x4*)(ng + ch); lg[q][1] = *(const GAS f32x4*)(ng + ch + 4); lb[q][0] = *(const GAS f32x4*)(nbias + ch); lb[q][1] = *(const GAS f32x4*)(nbias + ch + 4); }
#pragma unroll
            for (int q = 0; q < 4; ++q) { const int c8 = 8 * cq + 32 * q; float f[8]; unpack8(raw[q], f);
                const f32x4 g0 = lg[q][0], g1 = lg[q][1], b0 = lb[q][0], b1 = lb[q][1];
                const float gg[8] = {g0.x, g0.y, g0.z, g0.w, g1.x, g1.y, g1.z, g1.w}, bb[8] = {b0.x, b0.y, b0.z, b0.w, b1.x, b1.y, b1.z, b1.w};
#pragma unroll
                for (int e = 0; e < 8; ++e) tile[(c8 + e) * TP + srow] = (bf16)f2bf((f[e] - st.x) * st.y * gg[e] + bb[e]); }
            if (gi < 3) {
#pragma unroll
                for (int q = 0; q < 4; ++q) raw[q] = *(const GAS v4u*)(z + (size_t)(row0 + srow) * ZP + 1024 + (g + 1) * 128 + 8 * cq + 32 * q); }
            const int t = 16 * wave + fr, row = row0 + t; const float bias = sgub[g * 128 + t];
            v2u uw[8];
#pragma unroll
            for (int ct = 0; ct < 8; ++ct) uw[ct] = *(const GAS v2u*)(z + (size_t)row * ZP + g * 128 + ct * 16 + 4 * fq);
            bf16x8 wf[4];
#pragma unroll
            for (int kk = 0; kk < 4; ++kk) wf[kk] = *(const GAS bf16x8*)(sguw + ((size_t)g * 128 + 16 * wave + fr) * 128 + kk * 32 + 8 * fq);
            LDS_WAIT(); __syncthreads();
            A4 acc[8];
#pragma unroll
            for (int ct = 0; ct < 8; ++ct) acc[ct] = (A4){0.f, 0.f, 0.f, 0.f};
#pragma unroll
            for (int kk = 0; kk < 4; ++kk) { if (kk < 2 || wave >= 4) {
#pragma unroll
                for (int ct = 0; ct < 8; ++ct) { const bf16x8 vf = *(const LAS bf16x8*)(tile + (ct * 16 + fr) * TP + kk * 32 + 8 * fq);
                    acc[ct] = __builtin_amdgcn_mfma_f32_16x16x32_bf16(vf, wf[kk], acc[ct], 0, 0, 0); } } }
#pragma unroll
            for (int ct = 0; ct < 8; ++ct) { const int col = g * 128 + ct * 16 + 4 * fq;
                v2u o; o.x = pk2(bflo(uw[ct].x) * (acc[ct][0] + bias), bfhi(uw[ct].x) * (acc[ct][1] + bias)); o.y = pk2(bflo(uw[ct].y) * (acc[ct][2] + bias), bfhi(uw[ct].y) * (acc[ct][3] + bias));
                *(GAS v2u*)(ycat + (size_t)row * D + col) = o; }
        }
        LDS_WAIT(); __syncthreads();
        if (half == 0) {
            const int c8 = 8 * lane; float cw[3][8];
#pragma unroll
            for (int k = 0; k < 3; ++k) { const f32x4 a = *(const GAS f32x4*)(convw + k * 512 + c8), b = *(const GAS f32x4*)(convw + k * 512 + c8 + 4);
                cw[k][0] = a.x; cw[k][1] = a.y; cw[k][2] = a.z; cw[k][3] = a.w; cw[k][4] = b.x; cw[k][5] = b.y; cw[k][6] = b.z; cw[k][7] = b.w; }
            float y2[8], y1[8];
            { const int r0 = row0 + 16 * wave, ts = r0 % SEQ;
#pragma unroll
              for (int e = 0; e < 8; ++e) { y2[e] = 0.f; y1[e] = 0.f; }
              if (ts >= 2) { const bf16* zr2 = z + (size_t)(r0 - 2) * ZP + 2048; const bf16* zr1 = zr2 + ZP; float c[8], x[8];
                  const v4u c2 = *(const GAS v4u*)(zr2 + 512 + c8), x2 = *(const GAS v4u*)(zr2 + 1024 + c8), c1 = *(const GAS v4u*)(zr1 + 512 + c8), x1 = *(const GAS v4u*)(zr1 + 1024 + c8);
                  unpack8(c2, c); unpack8(x2, x);
#pragma unroll
                  for (int e = 0; e < 8; ++e) y2[e] = c[e] * x[e];
                  unpack8(c1, c); unpack8(x1, x);
#pragma unroll
                  for (int e = 0; e < 8; ++e) y1[e] = c[e] * x[e]; } }
            for (int tb = 0; tb < 4; ++tb) { v4u rb[4], rc[4], rx[4];
#pragma unroll
                for (int tt = 0; tt < 4; ++tt) { const bf16* zr = z + (size_t)(row0 + 16 * wave + 4 * tb + tt) * ZP + 2048; rb[tt] = *(const GAS v4u*)(zr + c8); rc[tt] = *(const GAS v4u*)(zr + 512 + c8); rx[tt] = *(const GAS v4u*)(zr + 1024 + c8); }
#pragma unroll
                for (int tt = 0; tt < 4; ++tt) { const int row = row0 + 16 * wave + 4 * tb + tt; float b[8], c[8], x[8], o[8]; unpack8(rb[tt], b); unpack8(rc[tt], c); unpack8(rx[tt], x);
#pragma unroll
                    for (int e = 0; e < 8; ++e) { const float y0 = c[e] * x[e]; o[e] = b[e] * (cw[0][e] * y2[e] + cw[1][e] * y1[e] + cw[2][e] * y0); y2[e] = y1[e]; y1[e] = y0; }
                    v4u w; w.x = pk2(o[0], o[1]); w.y = pk2(o[2], o[3]); w.z = pk2(o[4], o[5]); w.w = pk2(o[6], o[7]);
                    *(GAS v4u*)(ycat + (size_t)row * D + 1024 + c8) = w; } }
        } else {
            const int oct = tid & 15, tq = tid >> 4, c8 = 8 * oct, tbase = 4 * tq, tsb = (row0 + tbase) % SEQ;
#pragma unroll
            for (int g = 0; g < 4; ++g) { constexpr int WMAX = 16; const int W = 2 << g; LAS bf16* tile = tile0 + (g & 1) * TILE_ELEMS;
                asm volatile("" ::: "memory");
                const bf16* xp = z + (size_t)(row0 + tbase) * ZP + 3584 + g * 128 + c8;
                float sw[4][8];
#pragma unroll
                for (int tt = 0; tt < 4; ++tt)
#pragma unroll
                    for (int e = 0; e < 8; ++e) sw[tt][e] = 0.f;
#pragma unroll
                for (int kb = 0; kb < WMAX + 3; kb += 8) if (kb < W + 3) { v4u rr[8];
#pragma unroll
                    for (int kk = 0; kk < 8; ++kk) if (kb + kk < W + 3) { const int back = W - 1 - (kb + kk);
                        rr[kk] = (tsb - back >= 0) ? *(const GAS v4u*)(xp - (ptrdiff_t)back * ZP) : (v4u){0u, 0u, 0u, 0u}; }
#pragma unroll
                    for (int kk = 0; kk < 8; ++kk) if (kb + kk < W + 3) { const int k = kb + kk; float x[8]; unpack8(rr[kk], x);
#pragma unroll
                        for (int tt = 0; tt < 4; ++tt) if (tt <= k && k <= tt + W - 1) {
#pragma unroll
                            for (int e = 0; e < 8; ++e) sw[tt][e] += x[e];
                            if (k == tt + W - 1) {
                                const int ts = tsb + tt, cnt = (ts + 1 < W) ? ts + 1 : W; const float ic = 1.0f / (float)cnt; v4u o;
                                o.x = pk2(sw[tt][0] * ic - x[0], sw[tt][1] * ic - x[1]); o.y = pk2(sw[tt][2] * ic - x[2], sw[tt][3] * ic - x[3]);
                                o.z = pk2(sw[tt][4] * ic - x[4], sw[tt][5] * ic - x[5]); o.w = pk2(sw[tt][6] * ic - x[6], sw[tt][7] * ic - x[7]);
                                *(LAS v4u*)(tile + (tbase + tt) * TP + c8) = o; } } }
                    asm volatile("" ::: "memory"); }
                bf16x8 wf[4];
#pragma unroll
                for (int kk = 0; kk < 4; ++kk) wf[kk] = *(const GAS bf16x8*)(poolwt + ((size_t)g * 128 + 16 * wave + fr) * 128 + kk * 32 + 8 * fq);
                const f32x4 sc = *(const GAS f32x4*)(pscale + g * 128 + 16 * wave + 4 * fq);
                LDS_WAIT(); __syncthreads();
                A4 acc[8];
#pragma unroll
                for (int tt = 0; tt < 8; ++tt) acc[tt] = (A4){0.f, 0.f, 0.f, 0.f};
#pragma unroll
                for (int kk = 0; kk < 4; ++kk)
#pragma unroll
                    for (int tt = 0; tt < 8; ++tt) { const bf16x8 pf = *(const LAS bf16x8*)(tile + (tt * 16 + fr) * TP + kk * 32 + 8 * fq);
                        acc[tt] = __builtin_amdgcn_mfma_f32_16x16x32_bf16(wf[kk], pf, acc[tt], 0, 0, 0); }
#pragma unroll
                for (int tt = 0; tt < 8; ++tt) { const int row = row0 + tt * 16 + fr;
                    v2u o; o.x = pk2(acc[tt][0] * sc.x, acc[tt][1] * sc.y); o.y = pk2(acc[tt][2] * sc.z, acc[tt][3] * sc.w);
                    *(GAS v2u*)(ycat + (size_t)row * D + 1536 + g * 128 + 16 * wave + 4 * fq) = o; }
            }
        }
        LDS_WAIT(); __syncthreads();
    }
}
__device__ __forceinline__ void final_row(const bf16* __restrict__ h, float* __restrict__ out, const float* __restrict__ g, int m, int lane) {
    const bf16* hr = h + (size_t)m * D; float* orow = out + (size_t)m * D; v4u w[4]; float s = 0.f;
#pragma unroll
    for (int j = 0; j < 4; ++j) { w[j] = *(const GAS v4u*)(hr + 512 * j + 8 * lane); s += sumsqh8(w[j]); }
    const float ri = 1.0f / sqrtf(wave_sum(s) * (1.0f / (float)D) + EPS);
#pragma unroll
    for (int j = 0; j < 4; ++j) { const f32x4 g0 = *(const GAS f32x4*)(g + 512 * j + 8 * lane), g1 = *(const GAS f32x4*)(g + 512 * j + 8 * lane + 4);
        *(GAS f32x4*)(orow + 512 * j + 8 * lane) = (f32x4){hlo(w[j].x), hhi(w[j].x), hlo(w[j].y), hhi(w[j].y)} * ri * g0;
        *(GAS f32x4*)(orow + 512 * j + 8 * lane + 4) = (f32x4){hlo(w[j].z), hhi(w[j].z), hlo(w[j].w), hhi(w[j].w)} * ri * g1; }
}
__device__ __forceinline__ void final_phase(Frame& F, const bf16* __restrict__ h, float* __restrict__ out, const float* __restrict__ g) {
    int tid_ = threadIdx.x; asm volatile("" : "+v"(tid_));
    const int lane = tid_ & 63, wave = __builtin_amdgcn_readfirstlane(tid_ >> 6);
    if (F.G == 256) {
        const int base = (F.vcu >> 5) * 2048 + (F.vcu & 31) * NWAVES + wave;
        for (int jj = 0; jj < 8; ++jj) final_row(h, out, g, base + 256 * jj, lane);
    } else { const int gw = F.vcu * NWAVES + wave, NGW = F.G * NWAVES; for (int m = gw; m < M; m += NGW) final_row(h, out, g, m, lane); }
}
struct Args { InPtrs in; float* out; unsigned char* ws; };
#ifndef MK_ONLY
#define MK_ONLY -1
#endif
#define PH(k) (MK_ONLY < 0 || MK_ONLY == (k))
#ifndef MK_DUP1_STEPA
#define MK_DUP1_STEPA 0
#endif
#ifndef MK_DUP1_STEP
#define MK_DUP1_STEP 1
#endif
#ifndef MK_WIDE3
#define MK_WIDE3 0
#endif
#ifndef MK_WIDE5
#define MK_WIDE5 0
#endif
#ifndef MK_WIDE9
#define MK_WIDE9 0
#endif
#ifndef MK_DUP
#define MK_DUP -1
#endif
__global__ void __launch_bounds__(NWAVES * 64, 2) mk_fwd(Args args) {
    extern __shared__ __attribute__((aligned(16))) unsigned char lds[];
    Frame F;
    F.lds = (LAS unsigned char*)lds;
    F.MISC = (volatile LAS unsigned*)(F.lds + MISC_OFF);
    F.tid = threadIdx.x; F.lane = F.tid & 63; F.wave = __builtin_amdgcn_readfirstlane(F.tid >> 6);
    F.G = gridDim.x; { const int bx = blockIdx.x; F.vcu = (F.G % 8 == 0) ? (bx % 8) * (F.G / 8) + bx / 8 : bx; }
    unsigned char* ws = args.ws;
    F.ctl = (gu32*)(ws + WS_CTL);
    for (int u = F.tid; u < (LDS_BYTES - LDSCTL_OFF) / 4; u += NWAVES * 64) ((LAS unsigned*)(F.lds + LDSCTL_OFF))[u] = 0u;
    __syncthreads();
    XcdBarrier bar; bar.bar = (unsigned*)(ws + WS_CTL) + CW_BAR; bar.x = xb_xcc_id(); bar.st = F.MISC + 8;
    if (F.tid == 0) F.MISC[11] = xb_add(&bar.bar[XB_XCNT(bar.x)], 1u);
    __syncthreads();
    const int xcc = __builtin_amdgcn_readfirstlane((int)bar.x), xrank = __builtin_amdgcn_readfirstlane((int)F.MISC[11]);
#define localmode ((int)F.MISC[12])
    u64* const ssb0 = (u64*)(ws + WS_CTL + SS_OFF);
#define ssb   ((u64*)(ws + WS_CTL + SS_OFF))
#define out   (args.out)
#define HB    ((bf16*)(ws + WS_HB))
#define HB2   ((bf16*)(ws + WS_HB2))
#define ZH    ((bf16*)(ws + WS_ZH))
#define YCAT  ((bf16*)(ws + WS_YCAT))
#define MB    ((bf16*)(ws + WS_MB))
#define PT    ((bf16*)(ws + WS_MTMP))
#define HID   ((bf16*)(ws + WS_HID))
#define HB8   (ws + WS_HB8)
#define HB8B  (ws + WS_HB8B)
#define WSC   ((const float*)(ws + WS_SC) + M)
#define ASCALE ((float*)(ws + WS_SC))
#define DUMF  ((float*)(ws + WS_DUM))
#define DUMB  ((bf16*)(ws + WS_MTMP))
#define wl    ((const unsigned char*)(ws + WS_W + (size_t)l * LAYER_W))
#define ss0   (ssb + (size_t)(4 * l) * M)
#define ss1   (ssb + (size_t)(4 * l + 1) * M)
#define ss2   (ssb + (size_t)(4 * l + 2) * M)
#define ss3   (ssb + (size_t)(4 * l + 3) * M)
#define ss4   (ssb + (size_t)(4 * l + 4) * M)
#define LAUNDER_WS() do { unsigned long long w_ = (unsigned long long)args.ws; asm volatile("" : "+s"(w_)); ws = (unsigned char*)w_; asm volatile("" : "+s"(ord)); } while (0)
    const int G = F.G; int ord = (int)blockIdx.x;
#ifndef MK_TAMP
#define MK_TAMP 16
#endif
#ifndef MK_TPROBE
#define MK_TPROBE 0
#endif
    unsigned long long tp_acc = 0ull, tp_prev = MK_TPROBE ? __builtin_amdgcn_s_memrealtime() : 0ull;
    const unsigned long long tp_c0 = (MK_TPROBE == 500) ? __builtin_amdgcn_s_memtime() : 0ull, tp_r0 = tp_prev;
#define SEAM(k) do { if (localmode && (k) != 0 && (k) != 2 && (k) != 3) xcd_local_barrier(bar); else xcd_barrier(bar); } while (0)
#define PHASE_END(k) do { if (MK_TPROBE) { const unsigned long long ta_ = __builtin_amdgcn_s_memrealtime(); SEAM(k); const unsigned long long te_ = __builtin_amdgcn_s_memrealtime(); \
        if (MK_TPROBE == 100 + (k)) tp_acc += ta_ - tp_prev; if (MK_TPROBE == 200 || MK_TPROBE == 300 + (k) || (MK_TPROBE == 201 && (k) != 0 && (k) != 2 && (k) != 3) || (MK_TPROBE == 202 && ((k) == 2 || (k) == 3))) tp_acc += te_ - ta_; tp_prev = te_; } else SEAM(k); LAUNDER_WS(); } while (0)

    if (PH(0)) p0_prologue(F, args.in, ws, ssb0);
    PHASE_END(0);
    if (MK_DUP == 0) { p0_prologue(F, args.in, ws, ssb0); PHASE_END(0); }
    {
        if (F.tid == 0) { unsigned ok = (G == 256) ? 1u : 0u, npop = 0u;
            for (unsigned j = 0; j < 16; ++j) { const unsigned c = xb_ld(&bar.bar[XB_XCNT(j)]); if (c != 0u) { ++npop; if (c != 32u || j >= 8u) ok = 0u; } }
#if defined(MK_FORCE_GLOBAL)
            ok = 0u;
#endif
            F.MISC[12] = (ok && npop == 8u) ? 1u : 0u; }
        __syncthreads();
        if (localmode) { ord = __builtin_amdgcn_readfirstlane(xrank * 8 + xcc); F.vcu = __builtin_amdgcn_readfirstlane(xcc * 32 + xrank); }
    }
#ifndef MK_GATE_I8
#define MK_GATE_I8 1
#endif

    for (int l = 0; l < DEPTH; ++l) {
        if (PH(1))
        { SchedPlain S; S.T.init(M, 2 * FF, G, ord); S.A = (const char*)HB8B; S.B = (const char*)(wl + OW_GU1); S.astep = (size_t)256 * D; S.bstep = (size_t)256 * D * 2; S.nt = D / 128; S.T.wide = 1;
          EpiSwiglu8 E{HID, ss0, ssb + (size_t)(l == 0 ? 0 : 4 * l - 1) * M, WSC + DEPTH * (NGATE + D) + (l * 2 + 0) * (2 * FF), F.lds + EPI_AREA_OFF}; pg8::gemm_phase<EpiSwiglu8, SchedPlain, true>(F.lds + RING_OFF, D / 2, D, S, E); }
        PHASE_END(1);
        if (PH(2))
        { SchedPlain S; S.T.init(M, D, G, ord); S.A = (const char*)HID; S.B = (const char*)(wl + OW_D1); S.astep = (size_t)256 * FFP * 2; S.bstep = (size_t)256 * FF * 2; S.nt = FF / 64; S.T.wide = 1;
          EpiResid E{HB2, HB, ss1, nullptr, nullptr, ws + WS_HBB, 0.5f}; pg8::gemm_phase(F.lds + RING_OFF, 64, FF, S, E, 32768); }
        if (MK_GATE_I8) { PHASE_END(1); quant_h_phase(F, HB, HB8, ASCALE); }
        PHASE_END(2);
        if (MK_DUP == 1) {
        { SchedPlain S; S.T.init(M, 2 * FF, G, ord); S.A = (const char*)HB8B; S.B = (const char*)(wl + OW_GU1); S.astep = (size_t)256 * D * MK_DUP1_STEPA; S.bstep = (size_t)256 * D * 2 * MK_DUP1_STEP; S.nt = D / 128;
          EpiSwiglu8 E{HID, ss0, ssb + (size_t)(l == 0 ? 0 : 4 * l - 1) * M, WSC + DEPTH * (NGATE + D) + (l * 2 + 0) * (2 * FF), F.lds + EPI_AREA_OFF}; pg8::gemm_phase<EpiSwiglu8, SchedPlain, true>(F.lds + RING_OFF, D / 2, D, S, E); }
        PHASE_END(1); }
        if (MK_DUP == 2) {
        { SchedPlain S; S.T.init(M, D, G, ord); S.A = (const char*)HID; S.B = (const char*)(wl + OW_D1); S.astep = (size_t)256 * FFP * 2; S.bstep = (size_t)256 * FF * 2; S.nt = FF / 64;
          EpiResid E{HB2, DUMB, ssb + (size_t)17 * M, nullptr, nullptr, nullptr, 0.5f}; pg8::gemm_phase(F.lds + RING_OFF, 64, FF, S, E, 32768); }
        PHASE_END(2); }
        if (PH(3)) {
        { SchedPlain S; S.T.init(M, 4096, G, ord); S.A = (const char*)(ws + WS_HBB); S.B = (const char*)(wl + OW_IN); S.astep = (size_t)256 * D * 2; S.bstep = (size_t)256 * D * 2; S.nt = D / 64; S.T.wide = MK_WIDE3;
          EpiWin E{ZH, ss1, F.lds + EPI_AREA_OFF, 0}; pg8::gemm_phase(F.lds + RING_OFF, D, D, S, E); }
        if (MK_GATE_I8) {
          SchedPlain S; S.T.init(M, NGATE, G, ord); S.A = (const char*)HB8; S.B = (const char*)(wl + OW_IN) + (size_t)4096 * D * 2; S.astep = (size_t)256 * D; S.bstep = (size_t)256 * D * 2; S.nt = D / 128; S.T.wide = MK_WIDE3;
          EpiGate8 E{ws, F.lds + EPI_AREA_OFF, (unsigned)((const unsigned char*)ss1 - ws), (unsigned)(WS_SC + (size_t)(M + l * NGATE) * 4)}; pg8::gemm_phase<EpiGate8, SchedPlain, true>(F.lds + RING_OFF, D / 2, D, S, E);
        }
        }
        PHASE_END(3);
        if (MK_DUP == 3) {
        { SchedPlain S; S.T.init(M, NIN, G, ord); S.A = (const char*)HB; S.B = (const char*)(wl + OW_IN); S.astep = (size_t)256 * D * 2; S.bstep = (size_t)256 * D * 2; S.nt = D / 64;
          EpiWin E{ZH, ss1, F.lds + EPI_AREA_OFF, 0}; pg8::gemm_phase(F.lds + RING_OFF, D, D, S, E); }
        PHASE_END(3); }
        if (PH(4))
        mixer_phase(F, ZH, YCAT, args.in.p[8] + l * 1024, args.in.p[9] + l * 1024, (const bf16*)(wl + OW_SGU), args.in.p[11] + l * 1024, args.in.p[12] + l * 1536, (const bf16*)(wl + OW_POOL), args.in.p[14] + l * 512);
        PHASE_END(4);
        if (MK_DUP == 4) {
        mixer_phase(F, ZH, YCAT, args.in.p[8] + l * 1024, args.in.p[9] + l * 1024, (const bf16*)(wl + OW_SGU), args.in.p[11] + l * 1024, args.in.p[12] + l * 1536, (const bf16*)(wl + OW_POOL), args.in.p[14] + l * 512);
        PHASE_END(4); }
        if (PH(5))
        { SchedBranch S; S.T.init(M, D, G, ord); S.A = (const char*)YCAT; S.B = (const char*)(wl + OW_BR); S.astep = (size_t)256 * D * 2; S.bstep = (size_t)256 * D * 2; S.T.wide = MK_WIDE5;
          EpiBranch E{ZH, MB}; pg8::gemm_phase(F.lds + RING_OFF, D, D, S, E); }
        PHASE_END(5);
        if (MK_DUP == 5) {
        { SchedBranch S; S.T.init(M, D, G, ord); S.A = (const char*)YCAT; S.B = (const char*)(wl + OW_BR); S.astep = (size_t)256 * D * 2; S.bstep = (size_t)256 * D * 2;
          EpiBranch E{ZH, MB}; pg8::gemm_phase(F.lds + RING_OFF, D, D, S, E); }
        PHASE_END(5); }
        if (PH(6))
        { SchedPlain S; S.T.init(M, D, G, ord); S.A = (const char*)MB; S.B = (const char*)(wl + OW_OUT); S.astep = (size_t)256 * D * 2; S.bstep = (size_t)256 * D * 2; S.nt = D / 64; S.T.wide = MK_WIDE5;
          EpiResid E{HB, HB, ss2, HB8B, ss1, nullptr, 1.0f}; pg8::gemm_phase(F.lds + RING_OFF, D, D, S, E); }
        PHASE_END(6);
        if (MK_DUP == 6) {
        { SchedPlain S; S.T.init(M, D, G, ord); S.A = (const char*)MB; S.B = (const char*)(wl + OW_OUT); S.astep = (size_t)256 * D * 2; S.bstep = (size_t)256 * D * 2; S.nt = D / 64;
          EpiResid E{HB, DUMB, ssb + (size_t)17 * M, nullptr, nullptr, nullptr, 1.0f}; pg8::gemm_phase(F.lds + RING_OFF, D, D, S, E); }
        PHASE_END(6); }
        if (PH(7))
        { SchedPlain S; S.T.init(M, 2 * FF, G, ord); S.A = (const char*)HB8B; S.B = (const char*)(wl + OW_GU2); S.astep = (size_t)256 * D; S.bstep = (size_t)256 * D * 2; S.nt = D / 128; S.T.wide = 1;
          EpiSwiglu8 E{HID, ss2, ss1, WSC + DEPTH * (NGATE + D) + (l * 2 + 1) * (2 * FF), F.lds + EPI_AREA_OFF}; pg8::gemm_phase<EpiSwiglu8, SchedPlain, true>(F.lds + RING_OFF, D / 2, D, S, E); }
        PHASE_END(7);
        if (PH(8))
        { SchedPlain S; S.T.init(M, D, G, ord); S.A = (const char*)HID; S.B = (const char*)(wl + OW_D2); S.astep = (size_t)256 * FFP * 2; S.bstep = (size_t)256 * FF * 2; S.nt = FF / 64; S.T.wide = 1;
          EpiResid E{HB, HB, ss3, HB8, ss2, nullptr, 0.5f}; pg8::gemm_phase(F.lds + RING_OFF, 64, FF, S, E, 32768); }
        PHASE_END(8);
        if (MK_DUP == 8) {
        { SchedPlain S; S.T.init(M, D, G, ord); S.A = (const char*)HID; S.B = (const char*)(wl + OW_D2); S.astep = (size_t)256 * FFP * 2; S.bstep = (size_t)256 * FF * 2; S.nt = FF / 64;
          EpiResid E{HB, DUMB, ssb + (size_t)17 * M, nullptr, nullptr, nullptr, 0.5f}; pg8::gemm_phase(F.lds + RING_OFF, 64, FF, S, E, 32768); }
        PHASE_END(8); }
        if (PH(9)) {
        { SchedPlain S; S.T.init(M, D, G, ord); S.A = (const char*)(ws + WS_PCAT) + (size_t)l * DPLE * 2; S.B = (const char*)(wl + OW_P) + (size_t)D * 2; S.astep = (size_t)256 * D * 2; S.bstep = (size_t)256 * (D + DPLE) * 2; S.nt = DPLE / 64; S.T.wide = MK_WIDE9;
          EpiProj E{PT}; pg8::gemm_phase(F.lds + RING_OFF, D, D + DPLE, S, E); }
        { SchedPlain S; S.T.init(M, D, G, ord); S.A = (const char*)HB8; S.B = (const char*)(wl + OW_P); S.astep = (size_t)256 * D; S.bstep = (size_t)256 * (D + DPLE) * 2; S.nt = D / 128; S.T.wide = MK_WIDE9;
          EpiPleGate8 E{HB, HB2, PT, ss3, ss2, WSC + DEPTH * NGATE + l * D, ss4, HB8B, F.lds + EPI_AREA_OFF}; pg8::gemm_phase<EpiPleGate8, SchedPlain, true>(F.lds + RING_OFF, D / 2, D + DPLE, S, E); }
        }
        PHASE_END(9);
    }
    if (PH(10))
    final_phase(F, HB2, out, args.in.p[26]);
    if (MK_TPROBE == 500) { const unsigned long long dc = __builtin_amdgcn_s_memtime() - tp_c0, dr = __builtin_amdgcn_s_memrealtime() - tp_r0; tp_acc = (dc * 2500ull) / dr; }
    if (MK_TPROBE == 999 && localmode) tp_acc = 50000ull;
    if (MK_TPROBE) { if (MK_TPROBE == 110) tp_acc += __builtin_amdgcn_s_memrealtime() - tp_prev;
#ifndef MK_TBLOCK
#define MK_TBLOCK 0
#endif
        if (blockIdx.x == MK_TBLOCK) { const unsigned long long t0_ = __builtin_amdgcn_s_memrealtime(); while (__builtin_amdgcn_s_memrealtime() - t0_ < (unsigned long long)MK_TAMP * tp_acc) __builtin_amdgcn_s_sleep(8); } }
#undef PHASE_END
#undef localmode
#undef ssb
#undef out
#undef HB
#undef HB2
#undef ZH
#undef YCAT
#undef MB
#undef PT
#undef HID
#undef HB8
#undef HB8B
#undef WSC
#undef ASCALE
#undef DUMF
#undef DUMB
#undef wl
#undef ss0
#undef ss1
#undef ss2
#undef ss3
#undef ss4
#undef LAUNDER_WS
}

extern "C" void kernel_launch(void* const* d_in, const int* in_sizes, int n_in, void* d_out, int out_size, void* d_ws, size_t ws_size, hipStream_t stream) {
    static int grid = 0;
    if (grid == 0) {
        if (n_in != 27 || out_size != M * D || ws_size < WS_END) { fprintf(stderr, "kernel_launch: unexpected shapes: n_in %d out %d ws %zu (need %zu); nothing launched\n", n_in, out_size, ws_size, (size_t)WS_END); grid = -1; return; }
        int dev = 0, cus = 0, per_cu = 0;
        if (hipGetDevice(&dev) != hipSuccess || hipDeviceGetAttribute(&cus, hipDeviceAttributeMultiprocessorCount, dev) != hipSuccess) { fprintf(stderr, "kernel_launch: device query failed\n"); grid = -1; return; }
        if (hipFuncSetAttribute((const void*)mk_fwd, hipFuncAttributeMaxDynamicSharedMemorySize, LDS_BYTES) != hipSuccess) { fprintf(stderr, "kernel_launch: hipFuncSetAttribute failed\n"); grid = -1; return; }
        if (hipOccupancyMaxActiveBlocksPerMultiprocessor(&per_cu, (const void*)mk_fwd, NWAVES * 64, LDS_BYTES) != hipSuccess || per_cu < 1) { fprintf(stderr, "kernel_launch: occupancy query reports %d blocks per CU\n", per_cu); }
        (void)hipGetLastError();
        grid = cus;
    }
    if (grid < 0) return;
    if (hipMemsetAsync((char*)d_ws + WS_CTL, 0, CTL_ZERO_BYTES, stream) != hipSuccess) { fprintf(stderr, "kernel_launch: memset failed\n"); return; }
    Args a{};
    for (int i = 0; i < 27; ++i) a.in.p[i] = (const float*)d_in[i];
    a.out = (float*)d_out; a.ws = (unsigned char*)d_ws;
    hipLaunchKernelGGL(mk_fwd, dim3(grid), dim3(NWAVES * 64), LDS_BYTES, stream, a);
    const hipError_t le = hipPeekAtLastError();
    if (le != hipSuccess) fprintf(stderr, "kernel_launch: launch failed: %s\n", hipGetErrorName(le));
}
```

```cpp
#include <hip/hip_runtime.h>
#include <cstdio>
#include <cstdint>
namespace pg8 {
#define PG8_LAS __attribute__((address_space(3)))
typedef unsigned short bf16_t;
typedef short bf16x8 __attribute__((ext_vector_type(8)));
typedef float f32x4 __attribute__((ext_vector_type(4)));
typedef float f32x2 __attribute__((ext_vector_type(2)));
typedef unsigned u32x4 __attribute__((ext_vector_type(4)));
typedef unsigned u32x2 __attribute__((ext_vector_type(2)));
constexpr int BM = 256, BK = 64, HALF = 128, HTB = HALF * BK * 2  , STAGE_BYTES = 8 * HTB, NXCD = 8, WGM = 8;

__host__ __device__ __forceinline__ int lds_byte(int r, int c) { const int st = (r >> 4) * 2 + (c >> 5), rr = r & 15, cc = c & 31, ob = rr * 64 + cc * 2; return st * 1024 + (ob ^ (((ob >> 9) & 1) << 5)); }
__host__ __device__ __forceinline__ void stage_rc(int b, int& R, int& C) { const int st = b / 1024, sb = b % 1024, swz = sb ^ (((sb >> 9) & 1) << 5); R = (st >> 1) * 16 + swz / 64; C = (st & 1) * 32 + (swz % 64) / 2; }
__host__ __device__ __forceinline__ int perm32(int rho) { const int n = rho >> 4, i = rho & 15; return 8 * (i >> 2) + 4 * n + (i & 3); }

struct Unit { const char* A; const char* B; int nt; int pm, pn, kind, keep, par; };

struct TileOrder {
    int nM, nN, nwg, G, c, wide;
    __host__ __device__ void init(int M, int N, int G_, int c_) { nM = M / BM; nN = N / BM; nwg = nM * nN; G = G_; c = c_; wide = 0; }
    __host__ __device__ bool tile(int i, int& pm, int& pn) const {
        if (G == 256 && nM == 64) {
            const int L = i * 256 + c; if (L >= nwg) return false;
            const int xl = c & 7, off = i * 32 + (c >> 3);
            if (wide) { const int r = c >> 3, sr = i >> 1;
                if (8 * sr + 8 <= nN) { pm = 8 * xl + 4 * (i & 1) + (r >> 3); pn = 8 * sr + (r & 7); } else { pm = 8 * xl + (r & 7); pn = 8 * sr + (r >> 3); }
                pn += (xl * nN) >> 3; if (pn >= nN) pn -= nN; return true; }
            pm = 8 * xl + (off & 7); pn = (off >> 3) + ((xl * nN) >> 3); if (pn >= nN) pn -= nN; return true;
        }
        const long L = (long)i * G + c; if (L >= nwg) return false;
        int wgid = (int)L; { const int q = nwg / NXCD, r = nwg % NXCD, xcd = wgid % NXCD, off = wgid / NXCD; wgid = (xcd < r ? xcd * (q + 1) : r * (q + 1) + (xcd - r) * q) + off; }
        const int nig = WGM * nN, gid = wgid / nig, fm = gid * WGM, gsz = (nM - fm) < WGM ? (nM - fm) : WGM;
        pm = fm + ((wgid % nig) % gsz); pn = (wgid % nig) / gsz;
        { const int xl = (int)(L % NXCD); pn += (xl * nN) / NXCD; if (pn >= nN) pn -= nN; }
        return true;
    }
};

__device__ __forceinline__ unsigned cvt_pk_bf16(float lo, float hi) { unsigned r; asm volatile("v_cvt_pk_bf16_f32 %0, %1, %2" : "=v"(r) : "v"(lo), "v"(hi)); return r; }
__device__ __forceinline__ f32x2 gelu_pk(f32x2 v) {
    const f32x2 av = __builtin_elementwise_abs(v), d = av * 0.2316418882f + 1.0f;
    f32x2 t; t.x = __builtin_amdgcn_rcpf(d.x); t.y = __builtin_amdgcn_rcpf(d.y);
    f32x2 q = t * 0.5307027145f + (-0.7265760135f); q = q * t + 0.7107068705f; q = q * t + (-0.142248368f); q = q * t + 0.127414796f; q = q * t;
    const f32x2 s = (v * v) * (-0.72134752044f);
    f32x2 e; e.x = __builtin_amdgcn_exp2f(s.x); e.y = __builtin_amdgcn_exp2f(s.y);
    const f32x2 m = v * (q * e), r = v - m;
    f32x2 o; o.x = v.x < 0.f ? m.x : r.x; o.y = v.y < 0.f ? m.y : r.y; return o;
}

__device__ __forceinline__ void gelu_pk4(f32x2 (&v)[4]) {
    f32x2 d[4], s[4], t[4], e[4], q[4];
#pragma unroll
    for (int i = 0; i < 4; ++i) { d[i] = __builtin_elementwise_abs(v[i]) * 0.2316418882f + 1.0f; s[i] = (v[i] * v[i]) * (-0.72134752044f); }
#pragma unroll
    for (int i = 0; i < 4; ++i) { t[i].x = __builtin_amdgcn_rcpf(d[i].x); t[i].y = __builtin_amdgcn_rcpf(d[i].y); e[i].x = __builtin_amdgcn_exp2f(s[i].x); e[i].y = __builtin_amdgcn_exp2f(s[i].y); }
#pragma unroll
    for (int i = 0; i < 4; ++i) q[i] = t[i] * 0.5307027145f + (-0.7265760135f);
#pragma unroll
    for (int i = 0; i < 4; ++i) q[i] = q[i] * t[i] + 0.7107068705f;
#pragma unroll
    for (int i = 0; i < 4; ++i) q[i] = q[i] * t[i] + (-0.142248368f);
#pragma unroll
    for (int i = 0; i < 4; ++i) q[i] = q[i] * t[i] + 0.127414796f;
#pragma unroll
    for (int i = 0; i < 4; ++i) q[i] = (q[i] * t[i]) * e[i];
#pragma unroll
    for (int i = 0; i < 4; ++i) { const f32x2 m = v[i] * q[i], r = v[i] - m; v[i].x = v[i].x < 0.f ? m.x : r.x; v[i].y = v[i].y < 0.f ? m.y : r.y; }
}

typedef int i32x4 __attribute__((ext_vector_type(4)));
template <class E> struct EpiPrefetch { static constexpr bool on = false; };
template <bool I8> struct AccOf { typedef f32x4 type; };
template <> struct AccOf<true> { typedef i32x4 type; };
template <class Epi, class Sched, bool I8 = false>
__device__ __forceinline__ void gemm_phase(PG8_LAS unsigned char* lds, const int lda, const int ldb, const Sched S, const Epi E, const int kstepA_ = BK * 2) {
    typedef typename AccOf<I8>::type ACC;
    int tid_ = threadIdx.x; asm volatile("" : "+v"(tid_));
    const int tid = tid_, wid = __builtin_amdgcn_readfirstlane(tid >> 6), lane = tid & 63, wr = wid >> 2, wc = wid & 3, fr = lane & 15, fq = lane >> 4;
    unsigned voffA[2], voffB[2];
#pragma unroll
    for (int i = 0; i < 2; ++i) { int R, C; stage_rc(tid * 16 + i * 8192, R, C); const int Rb = (R & ~31) + perm32(R & 31);
        voffA[i] = (unsigned)(R * lda + C) * 2u; voffB[i] = (unsigned)(Rb * ldb + C) * 2u; }
    const size_t kstep = (size_t)(BK * 2), kstepA = (size_t)kstepA_;
    const size_t hstepA = (size_t)HALF * lda * 2, hstepB = (size_t)HALF * ldb * 2;
    const unsigned ldsw = (unsigned)wid * 1024u;
    const int aoff = lds_byte(wr * 64 + fr, fq * 8), boff = lds_byte(wc * 32 + fr, fq * 8);
#define PG8_SA(b, h) (((b) * 2 + (h)) * HTB)
#define PG8_SB(b, h) ((4 + (b) * 2 + (h)) * HTB)
#define PG8_STAGE(bufoff, gbase, voff) do { _Pragma("unroll") for (int _i = 0; _i < 2; ++_i) \
        __builtin_amdgcn_global_load_lds((const unsigned*)((const char*)(gbase) + (voff)[_i]), (PG8_LAS unsigned*)(lds + (bufoff) + ldsw + _i * 8192), 16, 0, 0); } while (0)
#define PG8_LDA(dst, b, h) do { _Pragma("unroll") for (int m = 0; m < 4; ++m) _Pragma("unroll") for (int k = 0; k < 2; ++k) dst[m][k] = *(const PG8_LAS bf16x8*)(lds + PG8_SA(b, h) + aoff + m * 2048 + k * 1024); } while (0)
#define PG8_LDB(dst, b, h) do { _Pragma("unroll") for (int n = 0; n < 2; ++n) _Pragma("unroll") for (int k = 0; k < 2; ++k) dst[n][k] = *(const PG8_LAS bf16x8*)(lds + PG8_SB(b, h) + boff + n * 2048 + k * 1024); } while (0)
#define PG8_MMA(ai, bj, At, Bt) do { __builtin_amdgcn_s_setprio(1); _Pragma("unroll") for (int m = 0; m < 4; ++m) _Pragma("unroll") for (int n = 0; n < 2; ++n) _Pragma("unroll") for (int k = 0; k < 2; ++k) \
        { if constexpr (I8) acc[ai][bj][m][n] = __builtin_amdgcn_mfma_i32_16x16x64_i8(__builtin_bit_cast(i32x4, Bt[n][k]), __builtin_bit_cast(i32x4, At[m][k]), acc[ai][bj][m][n], 0, 0, 0); \
          else acc[ai][bj][m][n] = __builtin_amdgcn_mfma_f32_16x16x32_bf16(Bt[n][k], At[m][k], acc[ai][bj][m][n], 0, 0, 0); } __builtin_amdgcn_s_setprio(0); } while (0)
#define PG8_WAIT_V(n) asm volatile("s_waitcnt vmcnt(" #n ")" ::: "memory")
#define PG8_WAIT_L(n) asm volatile("s_waitcnt lgkmcnt(" #n ")" ::: "memory")
#define PG8_BAR __builtin_amdgcn_s_barrier()
#define PG8_SCHED __builtin_amdgcn_sched_barrier(0)
    Unit cur, nxt; int ui = 0;
    if (!S.next(0, cur)) return;
    cur.par = 0;
    if constexpr (EpiPrefetch<Epi>::on) E.prefetch(cur, tid, wid);
    ACC acc[2][2][4][2]; const ACC acc_zero = {};
#pragma unroll
    for (int a = 0; a < 2; ++a)
#pragma unroll
        for (int b = 0; b < 2; ++b)
#pragma unroll
            for (int m = 0; m < 4; ++m)
#pragma unroll
                for (int n = 0; n < 2; ++n) acc[a][b][m][n] = acc_zero;
    bf16x8 At[4][2], B0[2][2], B1[2][2];
    const char* cA = cur.A; const char* cB = cur.B;
    PG8_STAGE(PG8_SB(0, 0), cB, voffB); PG8_STAGE(PG8_SB(0, 1), cB + hstepB, voffB); PG8_STAGE(PG8_SA(0, 0), cA, voffA); PG8_STAGE(PG8_SA(0, 1), cA + hstepA, voffA);
    if (wr == 1) PG8_BAR;
    PG8_WAIT_V(2); PG8_BAR;
    PG8_STAGE(PG8_SB(1, 0), cB + kstep, voffB); PG8_STAGE(PG8_SA(1, 0), cA + kstepA, voffA); PG8_STAGE(PG8_SB(1, 1), cB + hstepB + kstep, voffB);
    PG8_WAIT_V(6); PG8_BAR;
    for (;;) {
        const bool has_next = S.next(ui + 1, nxt); nxt.par = (ui + 1) & 1;
        const char* nA = has_next ? nxt.A : cA; const char* nB = has_next ? nxt.B : cB;
        const int nt = cur.nt;
        for (int t = 0; t < nt; t += 2) {
            const bool last = (t == nt - 2);
            const char* a1 = cA + (size_t)(t + 1) * kstepA;
            const char* a2 = last ? nA : cA + (size_t)(t + 2) * kstepA; const char* b2 = last ? nB : cB + (size_t)(t + 2) * kstep;
            const char* a3 = a2 + kstepA; const char* b3 = b2 + kstep;
            PG8_LDB(B0, 0, 0); PG8_LDB(B1, 0, 1); PG8_SCHED; PG8_LDA(At, 0, 0); PG8_STAGE(PG8_SA(1, 1), a1 + hstepA, voffA);
            PG8_WAIT_V(8); PG8_WAIT_L(0); PG8_BAR; PG8_MMA(0, 0, At, B0); PG8_MMA(0, 1, At, B1); PG8_BAR; PG8_SCHED;
            PG8_LDA(At, 0, 1); PG8_STAGE(PG8_SB(0, 0), b2, voffB); PG8_STAGE(PG8_SB(0, 1), b2 + hstepB, voffB); PG8_STAGE(PG8_SA(0, 0), a2, voffA);
            PG8_WAIT_V(8); PG8_WAIT_L(0); PG8_BAR; PG8_MMA(1, 0, At, B0); PG8_MMA(1, 1, At, B1); PG8_BAR; PG8_SCHED;
            PG8_LDB(B0, 1, 0); PG8_LDB(B1, 1, 1); PG8_SCHED; PG8_LDA(At, 1, 0); PG8_STAGE(PG8_SA(0, 1), a2 + hstepA, voffA);
            PG8_WAIT_V(8); PG8_WAIT_L(0); PG8_BAR; PG8_MMA(0, 0, At, B0); PG8_MMA(0, 1, At, B1); PG8_BAR; PG8_SCHED;
            PG8_LDA(At, 1, 1); PG8_STAGE(PG8_SB(1, 0), b3, voffB); PG8_STAGE(PG8_SB(1, 1), b3 + hstepB, voffB); PG8_STAGE(PG8_SA(1, 0), a3, voffA);
            PG8_WAIT_V(8); PG8_WAIT_L(0); PG8_BAR; PG8_MMA(1, 0, At, B0); PG8_MMA(1, 1, At, B1); PG8_BAR; PG8_SCHED;
        }
        if (wr == 0) PG8_BAR;
        E(acc, cur, wr, wc, fr, fq);
        if (!has_next) break;
        if (!cur.keep) {
#pragma unroll
        for (int a = 0; a < 2; ++a)
#pragma unroll
            for (int b = 0; b < 2; ++b)
#pragma unroll
                for (int m = 0; m < 4; ++m)
#pragma unroll
                    for (int n = 0; n < 2; ++n) acc[a][b][m][n] = acc_zero;
        }
        cur = nxt; cA = nA; cB = nB; ++ui;
        if constexpr (EpiPrefetch<Epi>::on) E.prefetch(cur, tid, wid);
        if (wr == 1) PG8_BAR;
    }
    PG8_WAIT_V(0);
    PG8_BAR;
#undef PG8_SA
#undef PG8_SB
#undef PG8_STAGE
#undef PG8_LDA
#undef PG8_LDB
#undef PG8_MMA
#undef PG8_WAIT_V
#undef PG8_WAIT_L
#undef PG8_BAR
#undef PG8_SCHED
}
}
constexpr int NWAVES = 8;
constexpr int BATCH = 4, SEQ = 4096, D = 2048, DEPTH = 4, FF = 5632, NIN = 10240, DPLE = 256;
#ifndef MK_FFP
#define MK_FFP FF
#endif
constexpr int FFP = MK_FFP;
constexpr int ZP = 4096 + 6144 / 2;
constexpr int M = BATCH * SEQ;
constexpr float EPS = 1e-6f;
constexpr size_t MiB = 1u << 20;
constexpr size_t WS_CTL = 0, CTL_ZERO_BYTES = 4 * MiB + 512 * 1024;
constexpr size_t WS_W = 8 * MiB;
constexpr size_t OW_GU1 = 0, OW_D1 = 44 * MiB, OW_IN = 66 * MiB, OW_BR = 106 * MiB, OW_OUT = 114 * MiB, OW_GU2 = 122 * MiB, OW_D2 = 166 * MiB, OW_P = 188 * MiB, OW_SGU = 197 * MiB, OW_POOL = 197 * MiB + 512 * 1024, LAYER_W = 198 * MiB;
constexpr size_t WS_ZH = WS_W + DEPTH * LAYER_W;
constexpr size_t WS_HBB = WS_ZH + 224 * MiB;
constexpr size_t WS_HB = WS_HBB + 64 * MiB;
constexpr size_t WS_PCAT = WS_HB + 64 * MiB;
constexpr size_t WS_YCAT = WS_PCAT + 64 * MiB;
constexpr size_t WS_MB = WS_YCAT + 64 * MiB;
constexpr size_t WS_MTMP = WS_MB + 64 * MiB;
constexpr size_t WS_HID = WS_MTMP + 64 * MiB;
constexpr size_t WS_HB2 = WS_HID + 176 * MiB;
constexpr size_t WS_HB8 = WS_HB2 + 64 * MiB;
constexpr size_t WS_HB8B = WS_HB8 + 32 * MiB;
constexpr size_t WS_SC = WS_HB8B + 32 * MiB;
constexpr int NGATE = 6144;
constexpr float Q_SIGMAS = 5.0f;
constexpr size_t WS_DUM = WS_SC + 1 * MiB;
#if defined(MK_DUP)
constexpr size_t WS_END = WS_DUM;
#else
constexpr size_t WS_END = WS_DUM;
#endif
constexpr int CW_BAR = 4096;
constexpr size_t SS_OFF = 1 * MiB;
constexpr int VS_SLOT0 = 18;
static_assert(SS_OFF + (size_t)(VS_SLOT0 + 2 * DEPTH) * M * 8 <= CTL_ZERO_BYTES, "CTL words inside the memset region");
typedef unsigned long long u64;
constexpr float SS_SCALE = 1048576.0f, SS_INV = 1.0f / 1048576.0f;
constexpr int RING_OFF = 0, RING_BYTES = 131072;
constexpr int LDSCTL_OFF = RING_BYTES, MISC_OFF = LDSCTL_OFF + 320;
constexpr int LDS_BYTES = 147456;
constexpr int EPI_AREA_OFF = MISC_OFF + 2048, EPI_AREA_BYTES = 5120;
static_assert(EPI_AREA_OFF + 2 * EPI_AREA_BYTES <= LDS_BYTES, "LDS map");

#define GAS __attribute__((address_space(1)))
#define LAS __attribute__((address_space(3)))
typedef unsigned short bf16;
typedef unsigned v4u __attribute__((ext_vector_type(4)));
typedef unsigned v2u __attribute__((ext_vector_type(2)));
typedef float f32x4 __attribute__((ext_vector_type(4)));
typedef float f32x2 __attribute__((ext_vector_type(2)));
typedef short bf16x8 __attribute__((ext_vector_type(8)));
typedef GAS unsigned gu32;
#define RLX_AGENT __ATOMIC_RELAXED, __HIP_MEMORY_SCOPE_AGENT
#define LDS_WAIT() asm volatile("s_waitcnt lgkmcnt(0)" ::: "memory")
#define VM_WAIT() asm volatile("s_waitcnt vmcnt(0)" ::: "memory")
__device__ __forceinline__ unsigned f2bf(float f) { unsigned u = __builtin_bit_cast(unsigned, f); return (u + 0x7fffu + ((u >> 16) & 1u)) >> 16; }
__device__ __forceinline__ unsigned pk2(float lo, float hi) { return f2bf(lo) | (f2bf(hi) << 16); }
__device__ __forceinline__ float bflo(unsigned w) { return __builtin_bit_cast(float, w << 16); }
__device__ __forceinline__ float bfhi(unsigned w) { return __builtin_bit_cast(float, w & 0xffff0000u); }
typedef _Float16 h16x2 __attribute__((ext_vector_type(2)));
__device__ __forceinline__ unsigned pkh2(float lo, float hi) { const h16x2 v = {(_Float16)lo, (_Float16)hi}; return __builtin_bit_cast(unsigned, v); }
__device__ __forceinline__ float hlo(unsigned w) { return (float)__builtin_bit_cast(h16x2, w).x; }
__device__ __forceinline__ float hhi(unsigned w) { return (float)__builtin_bit_cast(h16x2, w).y; }
__device__ __forceinline__ float fast_sigmoid(float x) { return __builtin_amdgcn_rcpf(1.0f + __builtin_amdgcn_exp2f(-1.44269504089f * x)); }
__device__ __forceinline__ float wave_sum(float v) {
#pragma unroll
    for (int o = 1; o < 64; o <<= 1) v += __shfl_xor(v, o);
    return v;
}
#define XB_TMO      128
#define XB_XCNT(j)  (256  + 64 * (j))
#define XB_XSUB(j)  (1280 + 64 * (j))
#define XB_XGEN(j)  (2304 + 64 * (j))
#define XB_TOP      3328
#define XB_TOPGEN   3392
#define XCD_BAR_WORDS 3456
#define XB_SPIN_CAP (1u << 18)

__device__ __forceinline__ unsigned xb_ld(unsigned* p)              { return __hip_atomic_load(p, __ATOMIC_RELAXED, __HIP_MEMORY_SCOPE_AGENT); }
__device__ __forceinline__ unsigned xb_add(unsigned* p, unsigned v) { return __hip_atomic_fetch_add(p, v, __ATOMIC_RELAXED, __HIP_MEMORY_SCOPE_AGENT); }
__device__ __forceinline__ unsigned xb_xcc_id() { return (unsigned)__builtin_amdgcn_s_getreg((3 << 11) | 20) & 0xFu; }
#define XB_SPIN(cond, bar) do { unsigned _sp = 0; while (cond) { __builtin_amdgcn_s_sleep(1); \
    if ((++_sp & 255u) == 0u) { if (xb_ld(&(bar)[XB_TMO])) break; if (_sp > XB_SPIN_CAP) { atomicAdd(&(bar)[XB_TMO], 1u); break; } } } } while (0)

struct XcdBarrier {
    unsigned* bar; unsigned x;
    volatile LAS unsigned* st;
};

__device__ __forceinline__ XcdBarrier xcd_barrier_post(unsigned* bar, volatile LAS unsigned* st) {
    XcdBarrier b; b.bar = bar; b.x = xb_xcc_id(); b.st = st;
    if (threadIdx.x == 0) (void)xb_add(&bar[XB_XCNT(b.x)], 1u);
    return b;
}
__device__ __forceinline__ void xcd_barrier_complete(unsigned* bar, unsigned x, unsigned& nloc, unsigned& nx) {
    const unsigned G = gridDim.x * gridDim.y * gridDim.z;
    unsigned sum, cnt, mine, sp = 0u;
    for (;;) {
        sum = 0u; cnt = 0u; mine = 0u;
#pragma unroll
        for (unsigned j = 0; j < 16; ++j) { const unsigned c = xb_ld(&bar[XB_XCNT(j)]); sum += c; cnt += (c > 0u) ? 1u : 0u; mine = (j == x) ? c : mine; }
        if (sum == G) break;
        __builtin_amdgcn_s_sleep(1);
        if ((++sp & 255u) == 0u) { if (xb_ld(&bar[XB_TMO])) break; if (sp > XB_SPIN_CAP) { atomicAdd(&bar[XB_TMO], 1u); break; } }
    }
    nloc = mine > 0u ? mine : 1u; nx = cnt > 0u ? cnt : 1u;
}

__device__ __forceinline__ void xcd_barrier(const XcdBarrier& b) {
    asm volatile("s_waitcnt vmcnt(0)" ::: "memory");
    __syncthreads();
    if (threadIdx.x == 0) {
        unsigned* bar = b.bar;
        unsigned bx = b.x; asm volatile("" : "+s"(bx));
        __builtin_amdgcn_s_waitcnt(0);
        unsigned nloc = b.st[0], nx = b.st[1];
        if (nloc == 0u) { xcd_barrier_complete(bar, bx, nloc, nx); b.st[0] = nloc; b.st[1] = nx; }
        const unsigned old = xb_add(&bar[XB_XSUB(bx)], 1u);
        const unsigned gen = old / nloc;
        if (old + 1u == (gen + 1u) * nloc) {
            __builtin_amdgcn_fence(__ATOMIC_RELEASE, "agent");
            asm volatile("s_waitcnt vmcnt(0)" ::: "memory");
            const unsigned og = xb_add(&bar[XB_TOP], 1u);
            const unsigned tg = og / nx;
            if (og + 1u == (tg + 1u) * nx) xb_add(&bar[XB_TOPGEN], 1u);
            else XB_SPIN(xb_ld(&bar[XB_TOPGEN]) == tg, bar);
            __builtin_amdgcn_fence(__ATOMIC_ACQUIRE, "agent");
            xb_add(&bar[XB_XGEN(bx)], 1u);
            asm volatile("s_waitcnt vmcnt(0)" ::: "memory");
        } else {
            XB_SPIN(xb_ld(&bar[XB_XGEN(bx)]) == gen, bar);
            __builtin_amdgcn_fence(__ATOMIC_ACQUIRE, "agent");
            asm volatile("s_waitcnt vmcnt(0)" ::: "memory");
        }
    }
    __syncthreads();
}


#define XB_LSUB(j)  (3520 + 64 * (j))
#define XB_LGEN(j)  (4544 + 64 * (j))
#define XCD_BAR_WORDS_EXT 5568
__device__ __forceinline__ void xcd_local_barrier(const XcdBarrier& b) {
    asm volatile("s_waitcnt vmcnt(0)" ::: "memory");
    __syncthreads();
    if (threadIdx.x == 0) {
        unsigned* bar = b.bar;
        unsigned bx = b.x; asm volatile("" : "+s"(bx));
        __builtin_amdgcn_s_waitcnt(0);
        const unsigned nloc = b.st[0];
        const unsigned old = xb_add(&bar[XB_LSUB(bx)], 1u);
        const unsigned gen = old / nloc;
        if (old + 1u == (gen + 1u) * nloc) xb_add(&bar[XB_LGEN(bx)], 1u);
        else XB_SPIN(xb_ld(&bar[XB_LGEN(bx)]) == gen, bar);
        __builtin_amdgcn_fence(__ATOMIC_ACQUIRE, "agent");
        asm volatile("s_waitcnt vmcnt(0)" ::: "memory");
    }
    __syncthreads();
}
struct Frame {
    LAS unsigned char* lds;
    volatile LAS unsigned* MISC;
    gu32* ctl;
    int tid, lane, wave;
    int vcu, G;
};

struct XItem { const float* W; const float* gv; bf16* WT; int ldw, dpitch, k0, n0; };
__device__ __forceinline__ void xitem_load(const XItem& x, int lane, f32x4 (&v)[8], float (&g)[8]) {
    const int kr = lane >> 3, n4 = (lane & 7) * 4;
#pragma unroll
    for (int i = 0; i < 8; ++i) { v[i] = __builtin_nontemporal_load((const GAS f32x4*)(x.W + (size_t)(x.k0 + 8 * i + kr) * x.ldw + x.n0 + n4));     g[i] = x.gv ? x.gv[x.k0 + 8 * i + kr] : 1.0f; }
}
__device__ __forceinline__ void xitem_store(const XItem& x, int lane, const f32x4 (&v)[8], const float (&g)[8], LAS float* scr) {
    const int kr = lane >> 3, n4 = (lane & 7) * 4;
#pragma unroll
    for (int i = 0; i < 8; ++i) { LAS float* s = scr + (8 * i + kr) * 33 + n4; s[0] = v[i].x * g[i]; s[1] = v[i].y * g[i]; s[2] = v[i].z * g[i]; s[3] = v[i].w * g[i]; }
    LDS_WAIT(); asm volatile("" ::: "memory");
    const int c = lane & 7;
#pragma unroll
    for (int j = 0; j < 4; ++j) { const int n = (lane >> 3) + 8 * j; const LAS float* s = scr + (8 * c) * 33 + n;
        v4u o; o.x = pk2(s[0 * 33], s[1 * 33]); o.y = pk2(s[2 * 33], s[3 * 33]); o.z = pk2(s[4 * 33], s[5 * 33]); o.w = pk2(s[6 * 33], s[7 * 33]);
        __builtin_nontemporal_store(o, (GAS v4u*)(x.WT + (size_t)n * x.dpitch + x.k0 + 8 * c)); }
    LDS_WAIT(); asm volatile("" ::: "memory");
}
struct InPtrs { const float* p[27]; };
constexpr int IT_DN = (FF / 64) * (D / 32), IT_IN = (D / 64) * (4096 / 32)  , IT_BA = (1024 / 64) * (D / 32), IT_BB = (512 / 64) * (D / 32),
              IT_DD = (D / 64) * (D / 32), IT_PP = (DPLE / 64) * (D / 32), IT_PL = 4 * 2 * 4;
constexpr int IT_LAYER = 2 * IT_DN + IT_IN + IT_BA + 2 * IT_BB + IT_DD + IT_PP + IT_PL;
__device__ __forceinline__ void xmat(XItem& x, int mode, const float* W, int N, const float* gv, bf16* WT, int dpitch, int dk, int item) {
    const int nblk = N / 32, kb = item / nblk, nbk = item - kb * nblk, n0 = 32 * nbk;
    const int drow = (mode == 0) ? n0 : (256 * (n0 >> 7) + 128 * (mode - 1) + (n0 & 127));
    x.W = W; x.gv = gv; x.WT = WT + (size_t)drow * dpitch + dk; x.ldw = N; x.dpitch = dpitch; x.k0 = 64 * kb; x.n0 = n0;
}
__device__ __forceinline__ void xdecode(XItem& x, const InPtrs& I, unsigned char* ws, int it) {
    const int l = it / IT_LAYER; int r = it - l * IT_LAYER;
    unsigned char* wl = ws + WS_W + (size_t)l * LAYER_W;
    if (r < IT_DN) { xmat(x, 0, I.p[5] + (size_t)l * FF * D, D, nullptr, (bf16*)(wl + OW_D1), FF, 0, r); return; } r -= IT_DN;
    if (r < IT_IN) { const int nblk = 4096 / 32, kb = r / nblk, nbk = r - kb * nblk;
        x.W = I.p[7] + (size_t)l * D * NIN; x.gv = I.p[6] + l * D; x.WT = (bf16*)(wl + OW_IN) + (size_t)(32 * nbk) * D; x.ldw = NIN; x.dpitch = D; x.k0 = 64 * kb; x.n0 = 32 * nbk; return; } r -= IT_IN;
    if (r < IT_BA) { xmat(x, 0, I.p[15] + (size_t)l * 1024 * D, D, nullptr, (bf16*)(wl + OW_BR), D, 0, r); return; } r -= IT_BA;
    if (r < IT_BB) { xmat(x, 0, I.p[16] + (size_t)l * 512 * D, D, nullptr, (bf16*)(wl + OW_BR), D, 1024, r); return; } r -= IT_BB;
    if (r < IT_BB) { xmat(x, 0, I.p[17] + (size_t)l * 512 * D, D, nullptr, (bf16*)(wl + OW_BR), D, 1536, r); return; } r -= IT_BB;
    if (r < IT_DD) { xmat(x, 0, I.p[18] + (size_t)l * D * D, D, nullptr, (bf16*)(wl + OW_OUT), D, 0, r); return; } r -= IT_DD;
    if (r < IT_DN) { xmat(x, 0, I.p[22] + (size_t)l * FF * D, D, nullptr, (bf16*)(wl + OW_D2), FF, 0, r); return; } r -= IT_DN;
    if (r < IT_PP) { xmat(x, 0, I.p[25] + (size_t)l * DPLE * D, D, nullptr, (bf16*)(wl + OW_P), D + DPLE, D, r); return; } r -= IT_PP;
    { const int g = r >> 3, rr = r & 7; xmat(x, 0, I.p[13] + ((size_t)l * 4 + g) * 128 * 128, 128, nullptr, (bf16*)(wl + OW_POOL) + (size_t)g * 128 * 128, 128, 0, rr); }
}
constexpr int SL_FF = FF / 32, SL_G = 6144 / 32, SL_P = D / 32, SL_LAYER = 4 * SL_FF + SL_G + SL_P;
struct Slab { const float* W; const float* gv; unsigned char* dst; float* sc; int ldw, dpitch, n0; };
__device__ __forceinline__ void slab_decode(Slab& b, const InPtrs& I, unsigned char* ws, int s) {
    const int l = s / SL_LAYER; int r = s - l * SL_LAYER;
    unsigned char* wl = ws + WS_W + (size_t)l * LAYER_W; float* const sc = (float*)(ws + WS_SC) + M;
    if (r < 4 * SL_FF) { const int f = r / (2 * SL_FF), up = (r / SL_FF) & 1, nb = r % SL_FF, n0 = 32 * nb, drow = 256 * (n0 >> 7) + 128 * up + (n0 & 127);
        b.W = I.p[f ? (up ? 21 : 20) : (up ? 4 : 3)] + (size_t)l * D * FF; b.gv = I.p[f ? 19 : 2] + l * D; b.ldw = FF; b.n0 = n0; b.dpitch = D * 2;
        b.dst = wl + (f ? OW_GU2 : OW_GU1) + (size_t)drow * (D * 2); b.sc = sc + DEPTH * (6144 + D) + (l * 2 + f) * (2 * FF) + drow; return; }
    r -= 4 * SL_FF;
    if (r < SL_G) { b.W = I.p[7] + (size_t)l * D * NIN; b.gv = I.p[6] + l * D; b.ldw = NIN; b.n0 = 4096 + 32 * r; b.dpitch = D * 2;
        b.dst = wl + OW_IN + (size_t)(4096 + 32 * r) * (D * 2); b.sc = sc + l * 6144 + 32 * r; return; }
    r -= SL_G;
    b.W = I.p[24] + (size_t)l * D * D; b.gv = I.p[23] + l * D; b.ldw = D; b.n0 = 32 * r; b.dpitch = (D + DPLE) * 2;
    b.dst = wl + OW_P + (size_t)(32 * r) * ((D + DPLE) * 2); b.sc = sc + DEPTH * 6144 + l * D + 32 * r;
}
__device__ __forceinline__ void slab_pass(Frame& F, const InPtrs& I, unsigned char* ws) {
    LAS bf16* slab = (LAS bf16*)(F.lds + RING_OFF);
    LAS float* cm = (LAS float*)(F.lds + MISC_OFF + 128);
    const int lane = F.lane, wave = F.wave, kr = lane >> 3, n4 = (lane & 7) * 4;
    f32x4 va[8], vb[8]; float ga[8], gb[8];
#define SLAB_LOAD(B_, v, g, kb) do { _Pragma("unroll") for (int i = 0; i < 8; ++i) { const int k = 64 * (kb) + 8 * i + kr; v[i] = __builtin_nontemporal_load((const GAS f32x4*)((B_).W + (size_t)k * (B_).ldw + (B_).n0 + n4)); g[i] = (B_).gv[k]; } } while (0)
    Slab b; { const int s0 = F.vcu; if (s0 < DEPTH * SL_LAYER) { slab_decode(b, I, ws, s0); SLAB_LOAD(b, va, ga, wave); SLAB_LOAD(b, vb, gb, wave + 8); } }
    for (int s = F.vcu; s < DEPTH * SL_LAYER; s += F.G) {
        float cmax[4] = {0.f, 0.f, 0.f, 0.f};
#define SLAB_PUT(v, g, kb) do { _Pragma("unroll") for (int i = 0; i < 8; ++i) { const int k = 64 * (kb) + 8 * i + kr; const float x[4] = {v[i].x * g[i], v[i].y * g[i], v[i].z * g[i], v[i].w * g[i]}; \
            _Pragma("unroll") for (int j = 0; j < 4; ++j) { const unsigned hb = f2bf(x[j]); slab[(n4 + j) * 2048 + k] = (bf16)hb; cmax[j] = fmaxf(cmax[j], fabsf(bflo(hb))); } } } while (0)
        SLAB_PUT(va, ga, wave);      SLAB_LOAD(b, va, ga, wave + 16);
        SLAB_PUT(vb, gb, wave + 8);  SLAB_LOAD(b, vb, gb, wave + 24);
        Slab bn; const bool more = s + F.G < DEPTH * SL_LAYER; if (more) slab_decode(bn, I, ws, s + F.G);
        SLAB_PUT(va, ga, wave + 16); if (more) SLAB_LOAD(bn, va, ga, wave);
        SLAB_PUT(vb, gb, wave + 24); if (more) SLAB_LOAD(bn, vb, gb, wave + 8);
#undef SLAB_PUT
#pragma unroll
        for (int j = 0; j < 4; ++j) { float c = cmax[j]; c = fmaxf(c, __shfl_xor(c, 8)); c = fmaxf(c, __shfl_xor(c, 16)); c = fmaxf(c, __shfl_xor(c, 32)); if (kr == 0) cm[wave * 32 + n4 + j] = c; }
        LDS_WAIT(); __syncthreads();
#pragma unroll
        for (int rr = 0; rr < 4; ++rr) { const int n = 4 * wave + rr; float amax = 0.f;
#pragma unroll
            for (int w = 0; w < 8; ++w) amax = fmaxf(amax, cm[w * 32 + n]);
            const float sq = amax > 0.f ? 127.0f / amax : 0.f; unsigned q[8];
#pragma unroll
            for (int j = 0; j < 4; ++j) { const v4u w4 = *(const LAS v4u*)(slab + n * 2048 + 32 * lane + 8 * j); float t[8]; t[0] = bflo(w4.x); t[1] = bfhi(w4.x); t[2] = bflo(w4.y); t[3] = bfhi(w4.y); t[4] = bflo(w4.z); t[5] = bfhi(w4.z); t[6] = bflo(w4.w); t[7] = bfhi(w4.w);
                q[2 * j] = ((unsigned)(int)rintf(t[0] * sq) & 0xffu) | (((unsigned)(int)rintf(t[1] * sq) & 0xffu) << 8) | (((unsigned)(int)rintf(t[2] * sq) & 0xffu) << 16) | (((unsigned)(int)rintf(t[3] * sq) & 0xffu) << 24);
                q[2 * j + 1] = ((unsigned)(int)rintf(t[4] * sq) & 0xffu) | (((unsigned)(int)rintf(t[5] * sq) & 0xffu) << 8) | (((unsigned)(int)rintf(t[6] * sq) & 0xffu) << 16) | (((unsigned)(int)rintf(t[7] * sq) & 0xffu) << 24); }
            unsigned char* drow = b.dst + (size_t)n * b.dpitch + 32 * lane;
            __builtin_nontemporal_store((v4u){q[0], q[1], q[2], q[3]}, (GAS v4u*)drow); __builtin_nontemporal_store((v4u){q[4], q[5], q[6], q[7]}, (GAS v4u*)(drow + 16));
            if (lane == 0) b.sc[n] = amax * (1.0f / 127.0f); }
        LDS_WAIT(); __syncthreads();
        if (more) b = bn;
    }
#undef SLAB_LOAD
}
__device__ __forceinline__ void xconvert_range(Frame& F, const InPtrs& I, unsigned char* ws, int it0, int NIT) {
    int tid_ = threadIdx.x; asm volatile("" : "+v"(tid_));
    const int lane = tid_ & 63, wave = __builtin_amdgcn_readfirstlane(tid_ >> 6);
    LAS float* scr = (LAS float*)(F.lds + RING_OFF + wave * 16384);
    const int gw = F.vcu * NWAVES + wave, NGW = F.G * NWAVES;
    XItem xa, xb; f32x4 va[8], vb[8]; float ga[8], gb[8];
    int it = it0 + gw;
    if (it < NIT) { xdecode(xa, I, ws, it); xitem_load(xa, lane, va, ga); }
    while (it < NIT) {
        const int it1 = it + NGW;
        if (it1 < NIT) { xdecode(xb, I, ws, it1); xitem_load(xb, lane, vb, gb); }
        xitem_store(xa, lane, va, ga, scr);
        const int it2 = it1 + NGW;
        if (it1 >= NIT) break;
        if (it2 < NIT) { xdecode(xa, I, ws, it2); xitem_load(xa, lane, va, ga); }
        xitem_store(xb, lane, vb, gb, scr);
        it = it2;
    }
}
__device__ __forceinline__ void p0_prologue(Frame& F, const InPtrs& I, unsigned char* ws, u64* ss0) {
    LAS float* scr = (LAS float*)(F.lds + RING_OFF + F.wave * 16384);
    const int gw = F.vcu * NWAVES + F.wave, NGW = F.G * NWAVES, lane = F.lane;
    slab_pass(F, I, ws);
    xconvert_range(F, I, ws, 0, DEPTH * IT_LAYER);
    const size_t gt = (size_t)F.vcu * (NWAVES * 64) + F.tid, GT = (size_t)F.G * NWAVES * 64;
    for (size_t i = gt; i < (size_t)DEPTH * 8 * 128 * 128 / 8; i += GT) {
        const size_t e0 = i * 8; const int l = (int)(e0 / (8 * 128 * 128)), rem = (int)(e0 % (8 * 128 * 128)), t = (rem / 128) % 128, s0 = rem % 128;
        const f32x4 a = __builtin_nontemporal_load((const GAS f32x4*)(I.p[10] + e0)), b = __builtin_nontemporal_load((const GAS f32x4*)(I.p[10] + e0 + 4));
        v4u o; if ((s0 >> 6) <= (t >> 6)) { o.x = pk2(a.x, a.y); o.y = pk2(a.z, a.w); o.z = pk2(b.x, b.y); o.w = pk2(b.z, b.w); } else { o = (v4u){0u, 0u, 0u, 0u}; }
        __builtin_nontemporal_store(o, (GAS v4u*)((bf16*)(ws + WS_W + (size_t)l * LAYER_W + OW_SGU) + rem)); }
    for (size_t i = gt; i < (size_t)DEPTH * M * DPLE / 8; i += GT) {
        const size_t e0 = i * 8; const int l = (int)(e0 / ((size_t)M * DPLE)); const size_t rem = e0 % ((size_t)M * DPLE); const int m = (int)(rem / DPLE), j = (int)(rem % DPLE);
        const f32x4 a = __builtin_nontemporal_load((const GAS f32x4*)(I.p[1] + e0)), b = __builtin_nontemporal_load((const GAS f32x4*)(I.p[1] + e0 + 4));
        v4u o; o.x = pk2(a.x, a.y); o.y = pk2(a.z, a.w); o.z = pk2(b.x, b.y); o.w = pk2(b.z, b.w);
        __builtin_nontemporal_store(o, (GAS v4u*)((bf16*)(ws + WS_PCAT) + (size_t)m * D + l * DPLE + j)); }
#define XROW_LOAD(A_, B_, mm) do { const float* xr_ = I.p[0] + (size_t)(mm) * D; _Pragma("unroll") for (int j = 0; j < 4; ++j) { A_[j] = __builtin_nontemporal_load((const GAS f32x4*)(xr_ + 512 * j + 8 * lane)); B_[j] = __builtin_nontemporal_load((const GAS f32x4*)(xr_ + 512 * j + 8 * lane + 4)); } } while (0)
#define XROW_PROC(a, b, mm) do { const int mr_ = (mm); bf16* hr = (bf16*)(ws + WS_HB2) + (size_t)mr_ * D; unsigned char* qr = ws + WS_HB8B + (size_t)mr_ * D; float s = 0.f; \
        _Pragma("unroll") for (int j = 0; j < 4; ++j) s += (a[j].x * a[j].x + a[j].y * a[j].y) + (a[j].z * a[j].z + a[j].w * a[j].w) + (b[j].x * b[j].x + b[j].y * b[j].y) + (b[j].z * b[j].z + b[j].w * b[j].w); \
        s = wave_sum(s); const u64 sfix = (u64)(s * SS_SCALE + 0.5f); if (lane == 0) ss0[mr_] = sfix; \
        const float qs = (127.0f / Q_SIGMAS) * __builtin_amdgcn_rsqf(fmaf((float)(unsigned)(sfix >> 32), 4294967296.0f, (float)(unsigned)sfix) * (SS_INV / (float)D) + EPS); \
        _Pragma("unroll") for (int j = 0; j < 4; ++j) { v4u o; o.x = pkh2(a[j].x, a[j].y); o.y = pkh2(a[j].z, a[j].w); o.z = pkh2(b[j].x, b[j].y); o.w = pkh2(b[j].z, b[j].w); *(GAS v4u*)(hr + 512 * j + 8 * lane) = o; \
            unsigned q0 = 0u, q1 = 0u; const float av[4] = {a[j].x, a[j].y, a[j].z, a[j].w}, bv[4] = {b[j].x, b[j].y, b[j].z, b[j].w}; \
            _Pragma("unroll") for (int e = 0; e < 4; ++e) { q0 |= ((unsigned)(int)fminf(fmaxf(rintf(av[e] * qs), -127.0f), 127.0f) & 0xffu) << (8 * e); q1 |= ((unsigned)(int)fminf(fmaxf(rintf(bv[e] * qs), -127.0f), 127.0f) & 0xffu) << (8 * e); } \
            *(GAS v2u*)(qr + 512 * j + 8 * lane) = (v2u){q0, q1}; } } while (0)
    { f32x4 xa0[4], xb0[4], xa1[4], xb1[4]; int m = gw; if (m < M) XROW_LOAD(xa0, xb0, m);
      for (; m < M; m += 2 * NGW) { const int m1 = m + NGW, m2 = m1 + NGW;
          if (m1 < M) XROW_LOAD(xa1, xb1, m1);
          XROW_PROC(xa0, xb0, m);
          if (m2 < M) XROW_LOAD(xa0, xb0, m2);
          if (m1 < M) XROW_PROC(xa1, xb1, m1); } }
#undef XROW_LOAD
#undef XROW_PROC
}

struct SchedPlain {
    pg8::TileOrder T; const char* A; const char* B; size_t astep, bstep; int nt;
    __device__ __forceinline__ bool next(int i, pg8::Unit& u) const { int pm, pn; if (!T.tile(i, pm, pn)) return false; u.pm = pm; u.pn = pn; u.kind = 0; u.keep = 0; u.A = A + (size_t)pm * astep; u.B = B + (size_t)pn * bstep; u.nt = nt; return true; }
};
struct SchedBranch {
    pg8::TileOrder T; const char* A; const char* B; size_t astep, bstep;
    __device__ __forceinline__ bool next(int i, pg8::Unit& u) const { int pm, pn; const int ti = i / 3, sub = i - 3 * ti; if (!T.tile(ti, pm, pn)) return false; u.pm = pm; u.pn = pn; u.kind = sub; u.keep = (sub != 2);
        const size_t ko = sub == 0 ? 0 : (sub == 1 ? 2048 : 3072); u.A = A + (size_t)pm * astep + ko; u.B = B + (size_t)pn * bstep + ko; u.nt = sub == 0 ? 16 : 8; return true; }
};
struct SchedPle {
    pg8::TileOrder T; const char* Ap; const char* Ah; const char* B; size_t astep, bstep;
    __device__ __forceinline__ bool next(int i, pg8::Unit& u) const { int pm, pn; const int ti = i >> 1, sub = i & 1; if (!T.tile(ti, pm, pn)) return false; u.pm = pm; u.pn = pn; u.kind = sub; u.keep = 0;
        u.A = (sub == 0 ? Ap : Ah) + (size_t)pm * astep; u.B = B + (size_t)pn * bstep + (sub == 0 ? (size_t)D * 2 : 0); u.nt = sub == 0 ? DPLE / 64 : D / 64; return true; }
};

constexpr int GATE_BYTE0 = 4096 * 2;
typedef pg8::f32x4 A4;
__device__ __forceinline__ v4u pack8(const A4& a, const A4& b) { v4u w; w.x = pg8::cvt_pk_bf16(a[0], a[1]); w.y = pg8::cvt_pk_bf16(a[2], a[3]); w.z = pg8::cvt_pk_bf16(b[0], b[1]); w.w = pg8::cvt_pk_bf16(b[2], b[3]); return w; }
__device__ __forceinline__ v4u packh8(const A4& a, const A4& b) { v4u w; w.x = pkh2(a[0], a[1]); w.y = pkh2(a[2], a[3]); w.z = pkh2(b[0], b[1]); w.w = pkh2(b[2], b[3]); return w; }
__device__ __forceinline__ float dot2sq(const unsigned w, const float c) { const h16x2 h = __builtin_bit_cast(h16x2, w); return __builtin_amdgcn_fdot2(h, h, c, false); }
__device__ __forceinline__ float sumsqh8(const v4u w) { return dot2sq(w.w, dot2sq(w.z, dot2sq(w.y, dot2sq(w.x, 0.0f)))); }
__device__ __forceinline__ v2u ss_raw(const u64* ss, int row) { return *(const GAS v2u*)(ss + row); }
__device__ __forceinline__ float ss_cvt(const v2u w) { return fmaf((float)w.y, 4294967296.0f, (float)w.x) * (SS_INV / (float)D) + EPS; }
__device__ __forceinline__ float rinv_c(const v2u w) { return __builtin_amdgcn_rsqf(ss_cvt(w)); }
__device__ __forceinline__ float rms_c(const v2u w) { const float x = ss_cvt(w); return x * __builtin_amdgcn_rsqf(x); }
__device__ __forceinline__ float ssf(const u64* ss, int row) { const v2u w = *(const GAS v2u*)(ss + row); return fmaf((float)w.y, 4294967296.0f, (float)w.x); }
__device__ __forceinline__ float rinv_of(const u64* ss, int row) { return __builtin_amdgcn_rsqf(ssf(ss, row) * (SS_INV / (float)D) + EPS); }
__device__ __forceinline__ float rms_of(const u64* ss, int row) { const float x = ssf(ss, row) * (SS_INV / (float)D) + EPS; return x * __builtin_amdgcn_rsqf(x); }
__device__ __forceinline__ void ss_add(u64* ss, int row, float q) { (void)__hip_atomic_fetch_add((GAS u64*)(ss + row), (u64)(q * SS_SCALE + 0.5f), __ATOMIC_RELAXED, __HIP_MEMORY_SCOPE_AGENT); }

struct EpiSwiglu {
    bf16* hid; const u64* ss;
    __device__ __forceinline__ void operator()(A4 (&acc)[2][2][4][2], const pg8::Unit& u, int wr, int wc, int fr, int fq) const {
        const int row0 = u.pm * 256 + wr * 64 + fr, col0 = u.pn * 128 + wc * 32 + 8 * fq;
        v2u ra[2][4]; float rv[2][4];
#pragma unroll
        for (int ai = 0; ai < 2; ++ai)
#pragma unroll
            for (int m = 0; m < 4; ++m) ra[ai][m] = ss_raw(ss, row0 + ai * 128 + m * 16);
#pragma unroll
        for (int ai = 0; ai < 2; ++ai)
#pragma unroll
            for (int m = 0; m < 4; ++m) rv[ai][m] = rinv_c(ra[ai][m]);
#pragma unroll
        for (int ai = 0; ai < 2; ++ai)
#pragma unroll
            for (int m = 0; m < 4; ++m) { const int row = row0 + ai * 128 + m * 16; const float ri = rv[ai][m];
                A4 o[2];
#pragma unroll
                for (int n = 0; n < 2; ++n) { const A4 g = acc[ai][0][m][n] * ri, up = acc[ai][1][m][n] * ri;
#pragma unroll
                    for (int j = 0; j < 4; ++j) o[n][j] = g[j] * fast_sigmoid(g[j]) * up[j]; }
                *(GAS v4u*)(hid + (size_t)row * FFP + col0) = pack8(o[0], o[1]); }
    }
};
__device__ __forceinline__ float sumsq8(const v4u w) { const float a = bflo(w.x), b = bfhi(w.x), c = bflo(w.y), d = bfhi(w.y), e = bflo(w.z), f = bfhi(w.z), g = bflo(w.w), h = bfhi(w.w);
    return ((a * a + b * b) + (c * c + d * d)) + ((e * e + f * f) + (g * g + h * h)); }
__device__ __forceinline__ unsigned q8x4(const A4 v, float qs) {
    const float MAG = 12582912.0f;
    const f32x2 a = (f32x2){v[0], v[1]} * qs + MAG, b = (f32x2){v[2], v[3]} * qs + MAG;
    const unsigned x0 = __builtin_bit_cast(unsigned, __builtin_amdgcn_fmed3f(a.x, MAG - 127.0f, MAG + 127.0f)), x1 = __builtin_bit_cast(unsigned, __builtin_amdgcn_fmed3f(a.y, MAG - 127.0f, MAG + 127.0f));
    const unsigned x2 = __builtin_bit_cast(unsigned, __builtin_amdgcn_fmed3f(b.x, MAG - 127.0f, MAG + 127.0f)), x3 = __builtin_bit_cast(unsigned, __builtin_amdgcn_fmed3f(b.y, MAG - 127.0f, MAG + 127.0f));
    return __builtin_amdgcn_perm(__builtin_amdgcn_perm(x3, x2, 0x0c0c0400u), __builtin_amdgcn_perm(x1, x0, 0x0c0c0400u), 0x05040100u); }
struct EpiResid {
    const bf16* hin; bf16* hout; u64* ssout; unsigned char* h8; const u64* ssq; unsigned char* hbf; float scale;
    __device__ __forceinline__ void operator()(A4 (&acc)[2][2][4][2], const pg8::Unit& u, int wr, int wc, int fr, int fq) const {
        const int row0 = u.pm * 256 + wr * 64 + fr, col0 = u.pn * 256 + wc * 32 + 8 * fq;
        v4u o[4][2][2]; v2u rq[4][2];
#define RESID_LOAD(g) do { _Pragma("unroll") for (int mm = 0; mm < 2; ++mm) { const int row = row0 + ((g) >> 1) * 128 + (2 * ((g) & 1) + mm) * 16; \
            _Pragma("unroll") for (int bj = 0; bj < 2; ++bj) o[g][mm][bj] = *(const GAS v4u*)(hin + (size_t)row * D + col0 + bj * 128); \
            rq[g][mm] = h8 ? ss_raw(ssq, row) : (v2u){0u, 0u}; } } while (0)
#define RESID_COMP(g) do { _Pragma("unroll") for (int mm = 0; mm < 2; ++mm) { const int ai = (g) >> 1, m = 2 * ((g) & 1) + mm, row = row0 + ai * 128 + m * 16; float q = 0.f; const float qs = h8 ? rinv_c(rq[g][mm]) * (127.0f / Q_SIGMAS) : 0.f; \
            _Pragma("unroll") for (int bj = 0; bj < 2; ++bj) { const v4u ov = o[g][mm][bj]; const A4 a0 = acc[ai][bj][m][0], a1 = acc[ai][bj][m][1]; \
                const A4 v0 = {__builtin_fmaf(a0[0], scale, hlo(ov.x)), __builtin_fmaf(a0[1], scale, hhi(ov.x)), __builtin_fmaf(a0[2], scale, hlo(ov.y)), __builtin_fmaf(a0[3], scale, hhi(ov.y))}; \
                const A4 v1 = {__builtin_fmaf(a1[0], scale, hlo(ov.z)), __builtin_fmaf(a1[1], scale, hhi(ov.z)), __builtin_fmaf(a1[2], scale, hlo(ov.w)), __builtin_fmaf(a1[3], scale, hhi(ov.w))}; \
                const v4u w = packh8(v0, v1); *(GAS v4u*)(hout + (size_t)row * D + col0 + bj * 128) = w; q += sumsqh8(w); \
                if (h8) *(GAS v2u*)(h8 + (size_t)row * D + col0 + bj * 128) = (v2u){q8x4(v0, qs), q8x4(v1, qs)}; \
                if (hbf) *(GAS v4u*)(hbf + ((size_t)row * D + col0 + bj * 128) * 2) = pack8(v0, v1); } \
            q += __shfl_xor(q, 16); q += __shfl_xor(q, 32); \
            if (fq == 0) ss_add(ssout, row, q); } } while (0)
        RESID_LOAD(0); RESID_LOAD(1); RESID_COMP(0); RESID_LOAD(2); RESID_COMP(1); RESID_LOAD(3); RESID_COMP(2); RESID_COMP(3);
#undef RESID_LOAD
#undef RESID_COMP
    }
};
struct EpiWin {
    bf16* z; const u64* ss; LAS unsigned char* area; u64* vstat; int pn0;
    __device__ __forceinline__ void prefetch(const pg8::Unit& u, int tid, int wave) const { asm volatile("" : "+v"(tid));
        __builtin_amdgcn_global_load_lds((const unsigned*)(ss + (size_t)u.pm * 256) + tid, (LAS unsigned*)(area + u.par * EPI_AREA_BYTES + wave * 256), 4, 0, 0); }
    __device__ __forceinline__ void operator()(A4 (&acc)[2][2][4][2], const pg8::Unit& u, int wr, int wc, int fr, int fq) const {
        const int pnz = u.pn + pn0; const int row0 = u.pm * 256 + wr * 64 + fr, col0 = pnz * 256 + wc * 32 + 8 * fq; const int act = pnz < 8 ? 1 : 0;
        v2u ra[2][4]; float rv[2][4];
#pragma unroll
        for (int ai = 0; ai < 2; ++ai)
#pragma unroll
            for (int m = 0; m < 4; ++m) ra[ai][m] = *(const LAS v2u*)(area + u.par * EPI_AREA_BYTES + (wr * 64 + fr + ai * 128 + m * 16) * 8);
#pragma unroll
        for (int ai = 0; ai < 2; ++ai)
#pragma unroll
            for (int m = 0; m < 4; ++m) rv[ai][m] = rinv_c(ra[ai][m]);
        const bool isv = pnz >= 4;
        float vsa[2][4], vqa[2][4];
        if (act == 1) {
#pragma unroll
            for (int ai = 0; ai < 2; ++ai)
#pragma unroll
                for (int m = 0; m < 4; ++m) { const int row = row0 + ai * 128 + m * 16; const float ri = rv[ai][m]; float vs = 0.f, vq = 0.f;
#pragma unroll
                    for (int bj = 0; bj < 2; ++bj) { const A4 v0 = acc[ai][bj][m][0] * ri, v1 = acc[ai][bj][m][1] * ri;
                        f32x2 g[4] = {{v0[0], v0[1]}, {v0[2], v0[3]}, {v1[0], v1[1]}, {v1[2], v1[3]}}; pg8::gelu_pk4(g);
                        const v4u w = pack8((A4){g[0].x, g[0].y, g[1].x, g[1].y}, (A4){g[2].x, g[2].y, g[3].x, g[3].y});
                        *(GAS v4u*)(z + (size_t)row * ZP + col0 + bj * 128) = w;
                        vs += ((bflo(w.x) + bfhi(w.x)) + (bflo(w.y) + bfhi(w.y))) + ((bflo(w.z) + bfhi(w.z)) + (bflo(w.w) + bfhi(w.w))); vq += sumsq8(w); }
                    vsa[ai][m] = vs; vqa[ai][m] = vq; }
            if (isv) {
#pragma unroll
                for (int ai = 0; ai < 2; ++ai)
#pragma unroll
                    for (int m = 0; m < 4; ++m) { const int row = row0 + ai * 128 + m * 16; float vs = vsa[ai][m], vq = vqa[ai][m];
                        vs += __shfl_xor(vs, 16); vs += __shfl_xor(vs, 32); vq += __shfl_xor(vq, 16); vq += __shfl_xor(vq, 32);
                        if (fq == 0) { (void)__hip_atomic_fetch_add((GAS u64*)(vstat + row), (u64)(long long)rintf(vs * SS_SCALE), __ATOMIC_RELAXED, __HIP_MEMORY_SCOPE_AGENT);
                                       (void)__hip_atomic_fetch_add((GAS u64*)(vstat + M + row), (u64)(vq * SS_SCALE + 0.5f), __ATOMIC_RELAXED, __HIP_MEMORY_SCOPE_AGENT); } } }
        } else {
#pragma unroll
            for (int ai = 0; ai < 2; ++ai)
#pragma unroll
                for (int m = 0; m < 4; ++m) { const int row = row0 + ai * 128 + m * 16; const float ri = rv[ai][m];
#pragma unroll
                    for (int bj = 0; bj < 2; ++bj) *(GAS v4u*)(z + (size_t)row * ZP + col0 + bj * 128) = pack8(acc[ai][bj][m][0] * ri, acc[ai][bj][m][1] * ri); }
        }
    }
};
namespace pg8 { template <> struct EpiPrefetch<EpiWin> { static constexpr bool on = true; }; }
typedef pg8::i32x4 I4;
struct EpiGate8 {
    unsigned char* ws; LAS unsigned char* area; unsigned ssoff, wsoff;
    __device__ __forceinline__ void prefetch(const pg8::Unit& u, int tid, int wave) const { asm volatile("" : "+v"(tid));
        LAS unsigned char* base = area + u.par * EPI_AREA_BYTES + wave * 256;
        __builtin_amdgcn_global_load_lds((const unsigned*)(ws + ssoff + (size_t)u.pm * 2048) + tid, (LAS unsigned*)base, 4, 0, 0);
        if (wave < 4) { __builtin_amdgcn_global_load_lds((const unsigned*)(ws + WS_SC + (size_t)u.pm * 1024) + tid, (LAS unsigned*)(base + 2048), 4, 0, 0);
                        __builtin_amdgcn_global_load_lds((const unsigned*)(ws + wsoff + (size_t)u.pn * 1024) + tid, (LAS unsigned*)(base + 4096), 4, 0, 0); }
    }
    __device__ __forceinline__ void operator()(I4 (&acc)[2][2][4][2], const pg8::Unit& u, int wr, int wc, int fr, int fq) const {
        const int row0 = u.pm * 256 + wr * 64 + fr, col0 = u.pn * 256 + wc * 32 + 8 * fq;
        const LAS unsigned char* la = area + u.par * EPI_AREA_BYTES; const LAS float* lw = (const LAS float*)(la + 4096) + wc * 32 + 8 * fq;
        float rv[2][4];
#pragma unroll
        for (int ai = 0; ai < 2; ++ai)
#pragma unroll
            for (int m = 0; m < 4; ++m) { const int lr = wr * 64 + fr + ai * 128 + m * 16; rv[ai][m] = rinv_c(*(const LAS v2u*)(la + lr * 8)) * *(const LAS float*)(la + 2048 + lr * 4); }
#pragma unroll
        for (int bj = 0; bj < 2; ++bj) { const f32x4 w0 = *(const LAS f32x4*)(lw + bj * 128) * -1.44269504089f, w1 = *(const LAS f32x4*)(lw + bj * 128 + 4) * -1.44269504089f;
            const f32x2 wn[4] = {{w0[0], w0[1]}, {w0[2], w0[3]}, {w1[0], w1[1]}, {w1[2], w1[3]}};
#pragma unroll
            for (int ai = 0; ai < 2; ++ai)
#pragma unroll
                for (int m = 0; m < 4; ++m) { const int row = row0 + ai * 128 + m * 16; const float ri = rv[ai][m]; unsigned x[8];
                    f32x2 t2[4], d2[4], r2[4], w2[4];
#pragma unroll
                    for (int p = 0; p < 4; ++p) { const I4 av = acc[ai][bj][m][p >> 1]; const int j = 2 * (p & 1); const f32x2 a2 = {(float)av[j], (float)av[j + 1]}; t2[p] = a2 * (wn[p] * ri); }
#pragma unroll
                    for (int p = 0; p < 4; ++p) d2[p] = (f32x2){__builtin_amdgcn_exp2f(t2[p].x), __builtin_amdgcn_exp2f(t2[p].y)} + 1.0f;
#pragma unroll
                    for (int p = 0; p < 4; ++p) r2[p] = (f32x2){__builtin_amdgcn_rcpf(d2[p].x), __builtin_amdgcn_rcpf(d2[p].y)};
#pragma unroll
                    for (int p = 0; p < 4; ++p) w2[p] = r2[p] * 255.0f + 8388608.0f;
#pragma unroll
                    for (int p = 0; p < 4; ++p) { x[2 * p] = __builtin_bit_cast(unsigned, fmaxf(w2[p].x, 8388609.0f)); x[2 * p + 1] = __builtin_bit_cast(unsigned, fmaxf(w2[p].y, 8388609.0f)); }
                    const unsigned q0 = __builtin_amdgcn_perm(__builtin_amdgcn_perm(x[3], x[2], 0x0c0c0400u), __builtin_amdgcn_perm(x[1], x[0], 0x0c0c0400u), 0x05040100u);
                    const unsigned q1 = __builtin_amdgcn_perm(__builtin_amdgcn_perm(x[7], x[6], 0x0c0c0400u), __builtin_amdgcn_perm(x[5], x[4], 0x0c0c0400u), 0x05040100u);
                    *(GAS v2u*)(ws + WS_ZH + (size_t)row * (ZP * 2) + GATE_BYTE0 + col0 + bj * 128) = (v2u){q0, q1}; } }
    }
};
namespace pg8 { template <> struct EpiPrefetch<EpiGate8> { static constexpr bool on = true; }; }
__device__ __forceinline__ void u8x8_to_f(const v2u w, float (&f)[8]) {
    f[0] = (float)(w.x & 0xffu); f[1] = (float)((w.x >> 8) & 0xffu); f[2] = (float)((w.x >> 16) & 0xffu); f[3] = (float)(w.x >> 24);
    f[4] = (float)(w.y & 0xffu); f[5] = (float)((w.y >> 8) & 0xffu); f[6] = (float)((w.y >> 16) & 0xffu); f[7] = (float)(w.y >> 24); }
struct EpiBranch {
    const bf16* z; bf16* mb;
    __device__ __forceinline__ void operator()(A4 (&acc)[2][2][4][2], const pg8::Unit& u, int wr, int wc, int fr, int fq) const {
        const int row0 = u.pm * 256 + wr * 64 + fr, col0 = u.pn * 256 + wc * 32 + 8 * fq; const int kind = u.kind;
        const unsigned char* gbase = (const unsigned char*)z + GATE_BYTE0 + col0;
        v2u ga[4][2][2], gb[4][2][2];
#define BR_LOAD(g) do { _Pragma("unroll") for (int mm = 0; mm < 2; ++mm) _Pragma("unroll") for (int bj = 0; bj < 2; ++bj) { \
            const unsigned char* gp = gbase + (size_t)(row0 + ((g) >> 1) * 128 + (2 * ((g) & 1) + mm) * 16) * (ZP * 2) + bj * 128; \
            ga[g][mm][bj] = *(const GAS v2u*)(gp + kind * 2048); gb[g][mm][bj] = (kind != 2) ? *(const GAS v2u*)(gp + (kind + 1) * 2048) : (v2u){0u, 0u}; } } while (0)
#define BR_COMP(g) do { _Pragma("unroll") for (int mm = 0; mm < 2; ++mm) _Pragma("unroll") for (int bj = 0; bj < 2; ++bj) { const int ai = (g) >> 1, m = 2 * ((g) & 1) + mm; float a[8], b[8]; u8x8_to_f(ga[g][mm][bj], a); \
            if (kind != 2) { u8x8_to_f(gb[g][mm][bj], b); _Pragma("unroll") for (int j = 0; j < 8; ++j) a[j] *= __builtin_amdgcn_rcpf(b[j]); } \
            else { _Pragma("unroll") for (int j = 0; j < 8; ++j) a[j] *= (1.0f / 255.0f); } \
            acc[ai][bj][m][0] *= (A4){a[0], a[1], a[2], a[3]}; acc[ai][bj][m][1] *= (A4){a[4], a[5], a[6], a[7]}; \
            if (kind == 2) *(GAS v4u*)(mb + (size_t)(row0 + ai * 128 + m * 16) * D + col0 + bj * 128) = pack8(acc[ai][bj][m][0], acc[ai][bj][m][1]); } } while (0)
        BR_LOAD(0); BR_LOAD(1); BR_COMP(0); BR_LOAD(2); BR_COMP(1); BR_LOAD(3); BR_COMP(2); BR_COMP(3);
#undef BR_LOAD
#undef BR_COMP
    }
};
struct EpiPle {
    const bf16* hin; bf16* hout; bf16* tmp; const u64* ss; u64* ssout;
    __device__ __forceinline__ void operator()(A4 (&acc)[2][2][4][2], const pg8::Unit& u, int wr, int wc, int fr, int fq) const {
        const int row0 = u.pm * 256 + wr * 64 + fr, col0 = u.pn * 256 + wc * 32 + 8 * fq; const int kind = u.kind;
        if (kind == 0) {
#pragma unroll
            for (int ai = 0; ai < 2; ++ai)
#pragma unroll
                for (int m = 0; m < 4; ++m)
#pragma unroll
                    for (int bj = 0; bj < 2; ++bj) *(GAS v4u*)(tmp + (size_t)(row0 + ai * 128 + m * 16) * D + col0 + bj * 128) = pack8(acc[ai][bj][m][0], acc[ai][bj][m][1]);
        } else {
#pragma unroll
            for (int ai = 0; ai < 2; ++ai)
#pragma unroll
            for (int mh = 0; mh < 2; ++mh) {
                v4u o[2][2], t[2][2]; float ri[2];
#pragma unroll
                for (int mm = 0; mm < 2; ++mm) { const int row = row0 + ai * 128 + (2 * mh + mm) * 16; ri[mm] = rinv_of(ss, row);
#pragma unroll
                    for (int bj = 0; bj < 2; ++bj) { const size_t off = (size_t)row * D + col0 + bj * 128; o[mm][bj] = *(const GAS v4u*)(hin + off); t[mm][bj] = *(const GAS v4u*)(tmp + off); } }
#pragma unroll
                for (int mm = 0; mm < 2; ++mm) { const int m = 2 * mh + mm, row = row0 + ai * 128 + m * 16; float q = 0.f;
#pragma unroll
                    for (int bj = 0; bj < 2; ++bj) { const v4u ov = o[mm][bj], tv = t[mm][bj];
                        A4 g0 = acc[ai][bj][m][0] * ri[mm], g1 = acc[ai][bj][m][1] * ri[mm];
#pragma unroll
                        for (int j = 0; j < 4; ++j) { g0[j] = fast_sigmoid(g0[j]); g1[j] = fast_sigmoid(g1[j]); }
                        const A4 v0 = (A4){bflo(ov.x), bfhi(ov.x), bflo(ov.y), bfhi(ov.y)} + g0 * (A4){bflo(tv.x), bfhi(tv.x), bflo(tv.y), bfhi(tv.y)}, v1 = (A4){bflo(ov.z), bfhi(ov.z), bflo(ov.w), bfhi(ov.w)} + g1 * (A4){bflo(tv.z), bfhi(tv.z), bflo(tv.w), bfhi(tv.w)};
                        const v4u w = pack8(v0, v1); *(GAS v4u*)(hout + (size_t)row * D + col0 + bj * 128) = w; q += sumsq8(w); }
                    q += __shfl_xor(q, 16); q += __shfl_xor(q, 32);
                    if (fq == 0) ss_add(ssout, row, q); }
            }
        }
    }
};

struct EpiSwiglu8 {
    bf16* hid; const u64* ss; const u64* ssq; const float* wscale; LAS unsigned char* area;
    __device__ __forceinline__ void prefetch(const pg8::Unit& u, int tid, int wave) const { asm volatile("" : "+v"(tid));

        LAS unsigned char* base = area + u.par * EPI_AREA_BYTES + wave * 256;
        __builtin_amdgcn_global_load_lds((const unsigned*)(ss + (size_t)u.pm * 256) + tid, (LAS unsigned*)base, 4, 0, 0);
        __builtin_amdgcn_global_load_lds((const unsigned*)(ssq + (size_t)u.pm * 256) + tid, (LAS unsigned*)(base + 2048), 4, 0, 0);
        if (wave < 4) __builtin_amdgcn_global_load_lds((const unsigned*)(wscale + (size_t)u.pn * 256) + tid, (LAS unsigned*)(base + 4096), 4, 0, 0);
    }
    __device__ __forceinline__ void operator()(I4 (&acc)[2][2][4][2], const pg8::Unit& u, int wr, int wc, int fr, int fq) const {
        const int row0 = u.pm * 256 + wr * 64 + fr, col0 = u.pn * 128 + wc * 32 + 8 * fq, wrow0 = u.pn * 256 + wc * 32 + 8 * fq;
        bf16* const hblk = hid + ((size_t)(u.pm * (FF / 64) + u.pn * 2 + (wc >> 1)) * 256 + wr * 64 + fr) * 64 + (wc & 1) * 32 + 8 * fq;
        const LAS unsigned char* la = area + u.par * EPI_AREA_BYTES; const LAS float* lw = (const LAS float*)(la + 4096) + wc * 32 + 8 * fq;
        const f32x4 g0w = *(const LAS f32x4*)lw, g1w = *(const LAS f32x4*)(lw + 4), u0w = *(const LAS f32x4*)(lw + 128), u1w = *(const LAS f32x4*)(lw + 132);
        v2u ra[2][4], rb[2][4]; float rv[2][4];
#pragma unroll
        for (int ai = 0; ai < 2; ++ai)
#pragma unroll
            for (int m = 0; m < 4; ++m) { const int lr = (wr * 64 + fr + ai * 128 + m * 16) * 8; ra[ai][m] = *(const LAS v2u*)(la + lr); rb[ai][m] = *(const LAS v2u*)(la + 2048 + lr); }
#pragma unroll
        for (int ai = 0; ai < 2; ++ai)
#pragma unroll
            for (int m = 0; m < 4; ++m) rv[ai][m] = rinv_c(ra[ai][m]) * (Q_SIGMAS / 127.0f) * rms_c(rb[ai][m]);
        f32x2 gn[4], gu[4];
#pragma unroll
        for (int q = 0; q < 2; ++q) { const f32x4 gw = q ? g1w : g0w, uw = q ? u1w : u0w;
            gn[2 * q] = (f32x2){gw[0], gw[1]} * -1.44269504089f; gn[2 * q + 1] = (f32x2){gw[2], gw[3]} * -1.44269504089f;
            gu[2 * q] = (f32x2){gw[0], gw[1]} * (f32x2){uw[0], uw[1]}; gu[2 * q + 1] = (f32x2){gw[2], gw[3]} * (f32x2){uw[2], uw[3]}; }
#pragma unroll
        for (int ai = 0; ai < 2; ++ai)
#pragma unroll
            for (int m = 0; m < 4; ++m) { const float ri = rv[ai][m], ri2 = ri * ri; f32x2 o[4];
#pragma unroll
                for (int p = 0; p < 4; ++p) { const I4 ag = acc[ai][0][m][p >> 1], au = acc[ai][1][m][p >> 1]; const int j = 2 * (p & 1);
                    const f32x2 a2 = {(float)ag[j], (float)ag[j + 1]}, b2 = {(float)au[j], (float)au[j + 1]};
                    const f32x2 t2 = a2 * (gn[p] * ri);
                    const f32x2 d2 = (f32x2){__builtin_amdgcn_exp2f(t2.x), __builtin_amdgcn_exp2f(t2.y)} + 1.0f;
                    const f32x2 r2 = {__builtin_amdgcn_rcpf(d2.x), __builtin_amdgcn_rcpf(d2.y)};
                    o[p] = ((a2 * b2) * (gu[p] * ri2)) * r2; }
                v4u w; w.x = pg8::cvt_pk_bf16(o[0].x, o[0].y); w.y = pg8::cvt_pk_bf16(o[1].x, o[1].y); w.z = pg8::cvt_pk_bf16(o[2].x, o[2].y); w.w = pg8::cvt_pk_bf16(o[3].x, o[3].y);
                *(GAS v4u*)(hblk + (size_t)(ai * 128 + m * 16) * 64) = w; }
    }
};
namespace pg8 { template <> struct EpiPrefetch<EpiSwiglu8> { static constexpr bool on = true; }; }
struct EpiProj {
    bf16* tmp;
    __device__ __forceinline__ void operator()(A4 (&acc)[2][2][4][2], const pg8::Unit& u, int wr, int wc, int fr, int fq) const {
        const int row0 = u.pm * 256 + wr * 64 + fr, col0 = u.pn * 256 + wc * 32 + 8 * fq;
#pragma unroll
        for (int ai = 0; ai < 2; ++ai)
#pragma unroll
            for (int m = 0; m < 4; ++m)
#pragma unroll
                for (int bj = 0; bj < 2; ++bj) *(GAS v4u*)(tmp + (size_t)(row0 + ai * 128 + m * 16) * D + col0 + bj * 128) = pack8(acc[ai][bj][m][0], acc[ai][bj][m][1]);
    }
};
struct EpiPleGate8 {
    const bf16* hin; bf16* hout; const bf16* tmp; const u64* ss; const u64* ssq; const float* wscale; u64* ssout; unsigned char* h8; LAS unsigned char* area;
    __device__ __forceinline__ void prefetch(const pg8::Unit& u, int tid, int wave) const { asm volatile("" : "+v"(tid));
        LAS unsigned char* base = area + u.par * EPI_AREA_BYTES + wave * 256;
        __builtin_amdgcn_global_load_lds((const unsigned*)(ss + (size_t)u.pm * 256) + tid, (LAS unsigned*)base, 4, 0, 0);
        __builtin_amdgcn_global_load_lds((const unsigned*)(ssq + (size_t)u.pm * 256) + tid, (LAS unsigned*)(base + 2048), 4, 0, 0);
        if (wave < 4) __builtin_amdgcn_global_load_lds((const unsigned*)(wscale + (size_t)u.pn * 256) + tid, (LAS unsigned*)(base + 4096), 4, 0, 0);
    }
    __device__ __forceinline__ void operator()(I4 (&acc)[2][2][4][2], const pg8::Unit& u, int wr, int wc, int fr, int fq) const {
        const int row0 = u.pm * 256 + wr * 64 + fr, col0 = u.pn * 256 + wc * 32 + 8 * fq;
        const LAS unsigned char* la = area + u.par * EPI_AREA_BYTES; const LAS float* lw = (const LAS float*)(la + 4096) + wc * 32 + 8 * fq;
#pragma unroll
        for (int ai = 0; ai < 2; ++ai) {
            v2u ra[4], rb[4]; float rv[4], qq[4], qsv[4];
#pragma unroll
            for (int m = 0; m < 4; ++m) { const int lr = (wr * 64 + fr + ai * 128 + m * 16) * 8; ra[m] = *(const LAS v2u*)(la + lr); rb[m] = *(const LAS v2u*)(la + 2048 + lr); }
#pragma unroll
            for (int m = 0; m < 4; ++m) { const float r3 = rinv_c(ra[m]); rv[m] = r3 * (Q_SIGMAS / 127.0f) * rms_c(rb[m]); qq[m] = 0.f; qsv[m] = r3 * (127.0f / Q_SIGMAS); }
#pragma unroll
            for (int bj = 0; bj < 2; ++bj) { const f32x4 w0 = *(const LAS f32x4*)(lw + bj * 128), w1 = *(const LAS f32x4*)(lw + bj * 128 + 4);
                v4u o[4], t[4];
#pragma unroll
                for (int m = 0; m < 4; ++m) { const size_t off = (size_t)(row0 + ai * 128 + m * 16) * D + col0 + bj * 128; o[m] = *(const GAS v4u*)(hin + off); t[m] = *(const GAS v4u*)(tmp + off); }
#pragma unroll
                for (int m = 0; m < 4; ++m) { const int row = row0 + ai * 128 + m * 16; const float ri = rv[m]; const v4u ov = o[m], tv = t[m]; A4 g0, g1;
#pragma unroll
                    for (int j = 0; j < 4; ++j) { g0[j] = fast_sigmoid((float)acc[ai][bj][m][0][j] * ri * w0[j]); g1[j] = fast_sigmoid((float)acc[ai][bj][m][1][j] * ri * w1[j]); }
                    const A4 v0 = (A4){hlo(ov.x), hhi(ov.x), hlo(ov.y), hhi(ov.y)} + g0 * (A4){bflo(tv.x), bfhi(tv.x), bflo(tv.y), bfhi(tv.y)}, v1 = (A4){hlo(ov.z), hhi(ov.z), hlo(ov.w), hhi(ov.w)} + g1 * (A4){bflo(tv.z), bfhi(tv.z), bflo(tv.w), bfhi(tv.w)};
                    const v4u w = packh8(v0, v1); *(GAS v4u*)(hout + (size_t)row * D + col0 + bj * 128) = w; qq[m] += sumsqh8(w);
                    *(GAS v2u*)(h8 + (size_t)row * D + col0 + bj * 128) = (v2u){q8x4(v0, qsv[m]), q8x4(v1, qsv[m])}; } }
#pragma unroll
            for (int m = 0; m < 4; ++m) { float q = qq[m]; q += __shfl_xor(q, 16); q += __shfl_xor(q, 32); if (fq == 0) ss_add(ssout, row0 + ai * 128 + m * 16, q); }
        }
    }
};
namespace pg8 { template <> struct EpiPrefetch<EpiPleGate8> { static constexpr bool on = true; }; }
constexpr int TP = 136;
__device__ __forceinline__ void unpack8(const v4u w, float (&f)[8]) { f[0] = bflo(w.x); f[1] = bfhi(w.x); f[2] = bflo(w.y); f[3] = bfhi(w.y); f[4] = bflo(w.z); f[5] = bfhi(w.z); f[6] = bflo(w.w); f[7] = bfhi(w.w); }
template <bool SRC_F16>
__device__ __forceinline__ void quant_proc(const v4u (&w)[4], unsigned char* drow, float* sc, int lane) {
    float f[32];
    float amax = 0.f;
#pragma unroll
    for (int j = 0; j < 4; ++j) { float t[8];
        if (SRC_F16) { t[0] = hlo(w[j].x); t[1] = hhi(w[j].x); t[2] = hlo(w[j].y); t[3] = hhi(w[j].y); t[4] = hlo(w[j].z); t[5] = hhi(w[j].z); t[6] = hlo(w[j].w); t[7] = hhi(w[j].w); } else unpack8(w[j], t);
#pragma unroll
        for (int e = 0; e < 8; ++e) { f[8 * j + e] = t[e]; amax = fmaxf(amax, fabsf(t[e])); } }
#pragma unroll
    for (int o = 1; o < 64; o <<= 1) amax = fmaxf(amax, __shfl_xor(amax, o));
    const float s = amax > 0.f ? 127.0f / amax : 0.f;
    v4u o0, o1; unsigned q[8];
#pragma unroll
    for (int j = 0; j < 8; ++j) { const int a = (int)rintf(f[4 * j] * s), b = (int)rintf(f[4 * j + 1] * s), c = (int)rintf(f[4 * j + 2] * s), d = (int)rintf(f[4 * j + 3] * s);
        q[j] = ((unsigned)a & 0xffu) | (((unsigned)b & 0xffu) << 8) | (((unsigned)c & 0xffu) << 16) | (((unsigned)d & 0xffu) << 24); }
    o0 = (v4u){q[0], q[1], q[2], q[3]}; o1 = (v4u){q[4], q[5], q[6], q[7]};
    *(GAS v4u*)(drow + 32 * lane) = o0; *(GAS v4u*)(drow + 32 * lane + 16) = o1;
    if (lane == 0) *sc = amax * (1.0f / 127.0f);
}
template <bool SRC_F16>
__device__ __forceinline__ void quant_load(const bf16* srow, int lane, v4u (&w)[4]) {
#pragma unroll
    for (int j = 0; j < 4; ++j) w[j] = *(const GAS v4u*)(srow + 32 * lane + 8 * j); }
template <bool SRC_F16>
__device__ __forceinline__ void quant_row(const bf16* srow, unsigned char* drow, float* sc, int lane) { v4u w[4]; quant_load<SRC_F16>(srow, lane, w); quant_proc<SRC_F16>(w, drow, sc, lane); }
__device__ __forceinline__ void quant_h_phase(Frame& F, const bf16* __restrict__ h, unsigned char* __restrict__ h8, float* __restrict__ ascale) {
    int tid_ = threadIdx.x; asm volatile("" : "+v"(tid_));
    const int lane = tid_ & 63, wave = __builtin_amdgcn_readfirstlane(tid_ >> 6);
    if (F.G == 256) { const int base = (F.vcu >> 5) * 2048 + (F.vcu & 31) * NWAVES + wave;
        v4u wa[4], wb[4]; quant_load<true>(h + (size_t)base * D, lane, wa);
#pragma unroll
        for (int jj = 0; jj < 8; jj += 2) { const int m = base + 256 * jj;
            quant_load<true>(h + (size_t)(m + 256) * D, lane, wb); quant_proc<true>(wa, h8 + (size_t)m * D, ascale + m, lane);
            if (jj + 2 < 8) quant_load<true>(h + (size_t)(m + 512) * D, lane, wa); quant_proc<true>(wb, h8 + (size_t)(m + 256) * D, ascale + m + 256, lane); }
    } else { const int gw = F.vcu * NWAVES + wave, NGW = F.G * NWAVES; for (int m = gw; m < M; m += NGW) quant_row<true>(h + (size_t)m * D, h8 + (size_t)m * D, ascale + m, lane); }
}
__device__ __forceinline__ void mixer_phase(Frame& F, const bf16* __restrict__ z, bf16* __restrict__ ycat, const float* __restrict__ ng, const float* __restrict__ nbias, const bf16* __restrict__ sguw, const u64* __restrict__ vstat,
                                            const float* __restrict__ sgub, const float* __restrict__ convw, const bf16* __restrict__ poolwt, const float* __restrict__ pscale) {
    LAS f32x2* stats = (LAS f32x2*)(F.lds + RING_OFF);
    LAS bf16* tile0 = (LAS bf16*)(F.lds + RING_OFF + 1024);
    constexpr int TILE_ELEMS = 128 * TP + 64;
    int tid_ = threadIdx.x; asm volatile("" : "+v"(tid_));
    const int tid = tid_, lane = tid & 63, wave = __builtin_amdgcn_readfirstlane(tid >> 6), fr = lane & 15, fq = lane >> 4;
    for (int un = F.vcu; un < 2 * (M / 128); un += F.G) {
        const int nbk = un >> 1, half = un & 1, row0 = nbk * 128;
        if (tid < 128) { const v2u ws_ = *(const GAS v2u*)(vstat + row0 + tid), wq_ = *(const GAS v2u*)(vstat + M + row0 + tid);
            const float mean = fmaf((float)(int)ws_.y, 4294967296.0f, (float)ws_.x) * (SS_INV / 1024.0f), ex2 = fmaf((float)wq_.y, 4294967296.0f, (float)wq_.x) * (SS_INV / 1024.0f);
            stats[tid] = (f32x2){mean, __builtin_amdgcn_rsqf(fmaxf(ex2 - mean * mean, 0.f) + EPS)}; }
        const int srow = tid >> 2, cq = tid & 3;
        v4u raw[4];
#pragma unroll
        for (int q = 0; q < 4; ++q) raw[q] = __builtin_nontemporal_load((const GAS v4u*)(z + (size_t)(row0 + srow) * ZP + 1024 + (half * 4) * 128 + 8 * cq + 32 * q));
        LDS_WAIT(); __syncthreads();
        const f32x2 st = stats[srow];
        for (int gi = 0; gi < 4; ++gi) { const int g = half * 4 + gi; LAS bf16* tile = tile0 + (gi & 1) * TILE_ELEMS;
            f32x4 lg[4][2], lb[4][2];
#pragma unroll
            for (int q = 0; q < 4; ++q) { const int ch = g * 128 + 8 * cq + 32 * q; lg[q][0] = *(const GAS f32x4*)(ng + ch); lg[q][1] = *(const GAS f32x4*)(ng + ch + 4); lb[q][0] = *(const GAS f32x4*)(nbias + ch); lb[q][1] = *(const GAS f32x4*)(nbias + ch + 4); }
#pragma unroll
            for (int q = 0; q < 4; ++q) { const int c8 = 8 * cq + 32 * q; float f[8]; unpack8(raw[q], f);
                const f32x4 g0 = lg[q][0], g1 = lg[q][1], b0 = lb[q][0], b1 = lb[q][1];
                const float gg[8] = {g0.x, g0.y, g0.z, g0.w, g1.x, g1.y, g1.z, g1.w}, bb[8] = {b0.x, b0.y, b0.z, b0.w, b1.x, b1.y, b1.z, b1.w};
#pragma unroll
                for (int e = 0; e < 8; ++e) tile[(c8 + e) * TP + srow] = (bf16)f2bf((f[e] - st.x) * st.y * gg[e] + bb[e]); }
            if (gi < 3) {
#pragma unroll
                for (int q = 0; q < 4; ++q) raw[q] = __builtin_nontemporal_load((const GAS v4u*)(z + (size_t)(row0 + srow) * ZP + 1024 + (g + 1) * 128 + 8 * cq + 32 * q)); }
            const int t = 16 * wave + fr, row = row0 + t; const float bias = sgub[g * 128 + t];
            v2u uw[8];
#pragma unroll
            for (int ct = 0; ct < 8; ++ct) uw[ct] = __builtin_nontemporal_load((const GAS v2u*)(z + (size_t)row * ZP + g * 128 + ct * 16 + 4 * fq));
            bf16x8 wf[4];
#pragma unroll
            for (int kk = 0; kk < 4; ++kk) wf[kk] = *(const GAS bf16x8*)(sguw + ((size_t)g * 128 + 16 * wave + fr) * 128 + kk * 32 + 8 * fq);
            LDS_WAIT(); __syncthreads();
            A4 acc[8];
#pragma unroll
            for (int ct = 0; ct < 8; ++ct) acc[ct] = (A4){0.f, 0.f, 0.f, 0.f};
#pragma unroll
            for (int kk = 0; kk < 4; ++kk) { if (kk < 2 || wave >= 4) {
#pragma unroll
                for (int ct = 0; ct < 8; ++ct) { const bf16x8 vf = *(const LAS bf16x8*)(tile + (ct * 16 + fr) * TP + kk * 32 + 8 * fq);
                    acc[ct] = __builtin_amdgcn_mfma_f32_16x16x32_bf16(vf, wf[kk], acc[ct], 0, 0, 0); } } }
#pragma unroll
            for (int ct = 0; ct < 8; ++ct) { const int col = g * 128 + ct * 16 + 4 * fq;
                v2u o; o.x = pk2(bflo(uw[ct].x) * (acc[ct][0] + bias), bfhi(uw[ct].x) * (acc[ct][1] + bias)); o.y = pk2(bflo(uw[ct].y) * (acc[ct][2] + bias), bfhi(uw[ct].y) * (acc[ct][3] + bias));
                *(GAS v2u*)(ycat + (size_t)row * D + col) = o; }
        }
        LDS_WAIT(); __syncthreads();
        if (half == 0) {
            const int c8 = 8 * lane; float cw[3][8];
#pragma unroll
            for (int k = 0; k < 3; ++k) { const f32x4 a = *(const GAS f32x4*)(convw + k * 512 + c8), b = *(const GAS f32x4*)(convw + k * 512 + c8 + 4);
                cw[k][0] = a.x; cw[k][1] = a.y; cw[k][2] = a.z; cw[k][3] = a.w; cw[k][4] = b.x; cw[k][5] = b.y; cw[k][6] = b.z; cw[k][7] = b.w; }
            float y2[8], y1[8];
            { const int r0 = row0 + 16 * wave, ts = r0 % SEQ;
#pragma unroll
              for (int e = 0; e < 8; ++e) { y2[e] = 0.f; y1[e] = 0.f; }
              if (ts >= 2) { const bf16* zr2 = z + (size_t)(r0 - 2) * ZP + 2048; const bf16* zr1 = zr2 + ZP; float c[8], x[8];
                  const v4u c2 = __builtin_nontemporal_load((const GAS v4u*)(zr2 + 512 + c8)), x2 = __builtin_nontemporal_load((const GAS v4u*)(zr2 + 1024 + c8)), c1 = __builtin_nontemporal_load((const GAS v4u*)(zr1 + 512 + c8)), x1 = __builtin_nontemporal_load((const GAS v4u*)(zr1 + 1024 + c8));
                  unpack8(c2, c); unpack8(x2, x);
#pragma unroll
                  for (int e = 0; e < 8; ++e) y2[e] = c[e] * x[e];
                  unpack8(c1, c); unpack8(x1, x);
#pragma unroll
                  for (int e = 0; e < 8; ++e) y1[e] = c[e] * x[e]; } }
            for (int tb = 0; tb < 4; ++tb) { v4u rb[4], rc[4], rx[4];
#pragma unroll
                for (int tt = 0; tt < 4; ++tt) { const bf16* zr = z + (size_t)(row0 + 16 * wave + 4 * tb + tt) * ZP + 2048; rb[tt] = __builtin_nontemporal_load((const GAS v4u*)(zr + c8)); rc[tt] = __builtin_nontemporal_load((const GAS v4u*)(zr + 512 + c8)); rx[tt] = __builtin_nontemporal_load((const GAS v4u*)(zr + 1024 + c8)); }
#pragma unroll
                for (int tt = 0; tt < 4; ++tt) { const int row = row0 + 16 * wave + 4 * tb + tt; float b[8], c[8], x[8], o[8]; unpack8(rb[tt], b); unpack8(rc[tt], c); unpack8(rx[tt], x);
#pragma unroll
                    for (int e = 0; e < 8; ++e) { const float y0 = c[e] * x[e]; o[e] = b[e] * (cw[0][e] * y2[e] + cw[1][e] * y1[e] + cw[2][e] * y0); y2[e] = y1[e]; y1[e] = y0; }
                    v4u w; w.x = pk2(o[0], o[1]); w.y = pk2(o[2], o[3]); w.z = pk2(o[4], o[5]); w.w = pk2(o[6], o[7]);
                    *(GAS v4u*)(ycat + (size_t)row * D + 1024 + c8) = w; } }
        } else {
            const int oct = tid & 15, tq = tid >> 4, c8 = 8 * oct, tbase = 4 * tq, tsb = (row0 + tbase) % SEQ;
#pragma unroll
            for (int g = 0; g < 4; ++g) { constexpr int WMAX = 16; const int W = 2 << g; LAS bf16* tile = tile0 + (g & 1) * TILE_ELEMS;
                asm volatile("" ::: "memory");
                const bf16* xp = z + (size_t)(row0 + tbase) * ZP + 3584 + g * 128 + c8;
                float sw[4][8];
#pragma unroll
                for (int tt = 0; tt < 4; ++tt)
#pragma unroll
                    for (int e = 0; e < 8; ++e) sw[tt][e] = 0.f;
#pragma unroll
                for (int kb = 0; kb < WMAX + 3; kb += 8) if (kb < W + 3) { v4u rr[8];
#pragma unroll
                    for (int kk = 0; kk < 8; ++kk) if (kb + kk < W + 3) { const int back = W - 1 - (kb + kk);
                        rr[kk] = (tsb - back >= 0) ? *(const GAS v4u*)(xp - (ptrdiff_t)back * ZP) : (v4u){0u, 0u, 0u, 0u}; }
#pragma unroll
                    for (int kk = 0; kk < 8; ++kk) if (kb + kk < W + 3) { const int k = kb + kk; float x[8]; unpack8(rr[kk], x);
#pragma unroll
                        for (int tt = 0; tt < 4; ++tt) if (tt <= k && k <= tt + W - 1) {
#pragma unroll
                            for (int e = 0; e < 8; ++e) sw[tt][e] += x[e];
                            if (k == tt + W - 1) {
                                const int ts = tsb + tt, cnt = (ts + 1 < W) ? ts + 1 : W; const float ic = 1.0f / (float)cnt; v4u o;
                                o.x = pk2(sw[tt][0] * ic - x[0], sw[tt][1] * ic - x[1]); o.y = pk2(sw[tt][2] * ic - x[2], sw[tt][3] * ic - x[3]);
                                o.z = pk2(sw[tt][4] * ic - x[4], sw[tt][5] * ic - x[5]); o.w = pk2(sw[tt][6] * ic - x[6], sw[tt][7] * ic - x[7]);
                                *(LAS v4u*)(tile + (tbase + tt) * TP + c8) = o; } } }
                    asm volatile("" ::: "memory"); }
                bf16x8 wf[4];
#pragma unroll
                for (int kk = 0; kk < 4; ++kk) wf[kk] = *(const GAS bf16x8*)(poolwt + ((size_t)g * 128 + 16 * wave + fr) * 128 + kk * 32 + 8 * fq);
                const f32x4 sc = *(const GAS f32x4*)(pscale + g * 128 + 16 * wave + 4 * fq);
                LDS_WAIT(); __syncthreads();
                A4 acc[8];
#pragma unroll
                for (int tt = 0; tt < 8; ++tt) acc[tt] = (A4){0.f, 0.f, 0.f, 0.f};
#pragma unroll
                for (int kk = 0; kk < 4; ++kk)
#pragma unroll
                    for (int tt = 0; tt < 8; ++tt) { const bf16x8 pf = *(const LAS bf16x8*)(tile + (tt * 16 + fr) * TP + kk * 32 + 8 * fq);
                        acc[tt] = __builtin_amdgcn_mfma_f32_16x16x32_bf16(wf[kk], pf, acc[tt], 0, 0, 0); }
#pragma unroll
                for (int tt = 0; tt < 8; ++tt) { const int row = row0 + tt * 16 + fr;
                    v2u o; o.x = pk2(acc[tt][0] * sc.x, acc[tt][1] * sc.y); o.y = pk2(acc[tt][2] * sc.z, acc[tt][3] * sc.w);
                    *(GAS v2u*)(ycat + (size_t)row * D + 1536 + g * 128 + 16 * wave + 4 * fq) = o; }
            }
        }
        LDS_WAIT(); __syncthreads();
    }
}
__device__ __forceinline__ void final_load(const bf16* __restrict__ h, int m, int lane, v4u (&w)[4]) {
#pragma unroll
    for (int j = 0; j < 4; ++j) w[j] = __builtin_nontemporal_load((const GAS v4u*)(h + (size_t)m * D + 512 * j + 8 * lane)); }
__device__ __forceinline__ void final_proc(const v4u (&w)[4], float* __restrict__ out, const f32x4 (&gg)[4][2], int m, int lane) {
    float* orow = out + (size_t)m * D; float s = 0.f;
#pragma unroll
    for (int j = 0; j < 4; ++j) s += sumsqh8(w[j]);
    const float ri = __builtin_amdgcn_rsqf(wave_sum(s) * (1.0f / (float)D) + EPS);
#pragma unroll
    for (int j = 0; j < 4; ++j) {
        __builtin_nontemporal_store((f32x4){hlo(w[j].x), hhi(w[j].x), hlo(w[j].y), hhi(w[j].y)} * ri * gg[j][0], (GAS f32x4*)(orow + 512 * j + 8 * lane));
        __builtin_nontemporal_store((f32x4){hlo(w[j].z), hhi(w[j].z), hlo(w[j].w), hhi(w[j].w)} * ri * gg[j][1], (GAS f32x4*)(orow + 512 * j + 8 * lane + 4)); }
}
__device__ __forceinline__ void final_row(const bf16* __restrict__ h, float* __restrict__ out, const f32x4 (&gg)[4][2], int m, int lane) { v4u w[4]; final_load(h, m, lane, w); final_proc(w, out, gg, m, lane); }
__device__ __forceinline__ void final_phase(Frame& F, const bf16* __restrict__ h, float* __restrict__ out, const float* __restrict__ g) {
    int tid_ = threadIdx.x; asm volatile("" : "+v"(tid_));
    const int lane = tid_ & 63, wave = __builtin_amdgcn_readfirstlane(tid_ >> 6);
    f32x4 gg[4][2];
#pragma unroll
    for (int j = 0; j < 4; ++j) { gg[j][0] = *(const GAS f32x4*)(g + 512 * j + 8 * lane); gg[j][1] = *(const GAS f32x4*)(g + 512 * j + 8 * lane + 4); }
    if (F.G == 256) {
        const int base = (F.vcu >> 5) * 2048 + (F.vcu & 31) * NWAVES + wave;
        v4u wa[4], wb[4]; final_load(h, base, lane, wa);
#pragma unroll
        for (int jj = 0; jj < 8; jj += 2) { const int m = base + 256 * jj;
            final_load(h, m + 256, lane, wb); final_proc(wa, out, gg, m, lane);
            if (jj + 2 < 8) final_load(h, m + 512, lane, wa); final_proc(wb, out, gg, m + 256, lane); }
    } else { const int gw = F.vcu * NWAVES + wave, NGW = F.G * NWAVES; for (int m = gw; m < M; m += NGW) final_row(h, out, gg, m, lane); }
}
struct Args { InPtrs in; float* out; unsigned char* ws; };
#ifndef MK_ONLY
#define MK_ONLY -1
#endif
#define PH(k) (MK_ONLY < 0 || MK_ONLY == (k))
#ifndef MK_DUP1_STEPA
#define MK_DUP1_STEPA 0
#endif
#ifndef MK_DUP1_STEP
#define MK_DUP1_STEP 1
#endif
#ifndef MK_WIDE3
#define MK_WIDE3 0
#endif
#ifndef MK_WIDE5
#define MK_WIDE5 0
#endif
#ifndef MK_WIDE9
#define MK_WIDE9 0
#endif
#ifndef MK_DUP
#define MK_DUP -1
#endif
__global__ void __launch_bounds__(NWAVES * 64, 2) mk_fwd(Args args) {
    extern __shared__ __attribute__((aligned(16))) unsigned char lds[];
    Frame F;
    F.lds = (LAS unsigned char*)lds;
    F.MISC = (volatile LAS unsigned*)(F.lds + MISC_OFF);
    F.tid = threadIdx.x; F.lane = F.tid & 63; F.wave = __builtin_amdgcn_readfirstlane(F.tid >> 6);
    F.G = gridDim.x; { const int bx = blockIdx.x; F.vcu = (F.G % 8 == 0) ? (bx % 8) * (F.G / 8) + bx / 8 : bx; }
    unsigned char* ws = args.ws;
    F.ctl = (gu32*)(ws + WS_CTL);
    for (int u = F.tid; u < (LDS_BYTES - LDSCTL_OFF) / 4; u += NWAVES * 64) ((LAS unsigned*)(F.lds + LDSCTL_OFF))[u] = 0u;
    __syncthreads();
    XcdBarrier bar; bar.bar = (unsigned*)(ws + WS_CTL) + CW_BAR; bar.x = xb_xcc_id(); bar.st = F.MISC + 8;
    if (F.tid == 0) F.MISC[11] = xb_add(&bar.bar[XB_XCNT(bar.x)], 1u);
    __syncthreads();
    const int xcc = __builtin_amdgcn_readfirstlane((int)bar.x), xrank = __builtin_amdgcn_readfirstlane((int)F.MISC[11]);
#define localmode ((int)F.MISC[12])
    u64* const ssb0 = (u64*)(ws + WS_CTL + SS_OFF);
#define ssb   ((u64*)(ws + WS_CTL + SS_OFF))
#define out   (args.out)
#define HB    ((bf16*)(ws + WS_HB))
#define HB2   ((bf16*)(ws + WS_HB2))
#define ZH    ((bf16*)(ws + WS_ZH))
#define YCAT  ((bf16*)(ws + WS_YCAT))
#define MB    ((bf16*)(ws + WS_MB))
#define PT    ((bf16*)(ws + WS_MTMP))
#define HID   ((bf16*)(ws + WS_HID))
#define HB8   (ws + WS_HB8)
#define HB8B  (ws + WS_HB8B)
#define WSC   ((const float*)(ws + WS_SC) + M)
#define ASCALE ((float*)(ws + WS_SC))
#define DUMF  ((float*)(ws + WS_DUM))
#define DUMB  ((bf16*)(ws + WS_MTMP))
#define wl    ((const unsigned char*)(ws + WS_W + (size_t)l * LAYER_W))
#define ss0   (ssb + (size_t)(4 * l) * M)
#define ss1   (ssb + (size_t)(4 * l + 1) * M)
#define ss2   (ssb + (size_t)(4 * l + 2) * M)
#define ss3   (ssb + (size_t)(4 * l + 3) * M)
#define ss4   (ssb + (size_t)(4 * l + 4) * M)
#define LAUNDER_WS() do { unsigned long long w_ = (unsigned long long)args.ws; asm volatile("" : "+s"(w_)); ws = (unsigned char*)w_; asm volatile("" : "+s"(ord)); } while (0)
    const int G = F.G; int ord = (int)blockIdx.x;
#ifndef MK_TAMP
#define MK_TAMP 16
#endif
#ifndef MK_TPROBE
#define MK_TPROBE 0
#endif
    unsigned long long tp_acc = 0ull, tp_prev = MK_TPROBE ? __builtin_amdgcn_s_memrealtime() : 0ull;
    const unsigned long long tp_c0 = (MK_TPROBE == 500) ? __builtin_amdgcn_s_memtime() : 0ull, tp_r0 = tp_prev;
#define SEAM(k) do { if (localmode && (k) != 0 && (k) != 2 && (k) != 3) xcd_local_barrier(bar); else xcd_barrier(bar); } while (0)
#define PHASE_END(k) do { if (MK_TPROBE) { const unsigned long long ta_ = __builtin_amdgcn_s_memrealtime(); SEAM(k); const unsigned long long te_ = __builtin_amdgcn_s_memrealtime(); \
        if (MK_TPROBE == 100 + (k)) tp_acc += ta_ - tp_prev; if (MK_TPROBE == 200 || MK_TPROBE == 300 + (k) || (MK_TPROBE == 201 && (k) != 0 && (k) != 2 && (k) != 3) || (MK_TPROBE == 202 && ((k) == 2 || (k) == 3))) tp_acc += te_ - ta_; tp_prev = te_; } else SEAM(k); LAUNDER_WS(); } while (0)

    if (PH(0)) p0_prologue(F, args.in, ws, ssb0);
    PHASE_END(0);
    if (MK_DUP == 0) { p0_prologue(F, args.in, ws, ssb0); PHASE_END(0); }
    {
        if (F.tid == 0) { unsigned ok = (G == 256) ? 1u : 0u, npop = 0u;
            for (unsigned j = 0; j < 16; ++j) { const unsigned c = xb_ld(&bar.bar[XB_XCNT(j)]); if (c != 0u) { ++npop; if (c != 32u || j >= 8u) ok = 0u; } }
#if defined(MK_FORCE_GLOBAL)
            ok = 0u;
#endif
            F.MISC[12] = (ok && npop == 8u) ? 1u : 0u; }
        __syncthreads();
        if (localmode) { ord = __builtin_amdgcn_readfirstlane(xrank * 8 + xcc); F.vcu = __builtin_amdgcn_readfirstlane(xcc * 32 + xrank); }
    }
#ifndef MK_GATE_I8
#define MK_GATE_I8 1
#endif

    for (int l = 0; l < DEPTH; ++l) {
        if (PH(1))
        { SchedPlain S; S.T.init(M, 2 * FF, G, ord); S.A = (const char*)HB8B; S.B = (const char*)(wl + OW_GU1); S.astep = (size_t)256 * D; S.bstep = (size_t)256 * D * 2; S.nt = D / 128; S.T.wide = 1;
          EpiSwiglu8 E{HID, ss0, ssb + (size_t)(l == 0 ? 0 : 4 * l - 1) * M, WSC + DEPTH * (NGATE + D) + (l * 2 + 0) * (2 * FF), F.lds + EPI_AREA_OFF}; pg8::gemm_phase<EpiSwiglu8, SchedPlain, true>(F.lds + RING_OFF, D / 2, D, S, E); }
        PHASE_END(1);
        if (PH(2))
        { SchedPlain S; S.T.init(M, D, G, ord); S.A = (const char*)HID; S.B = (const char*)(wl + OW_D1); S.astep = (size_t)256 * FFP * 2; S.bstep = (size_t)256 * FF * 2; S.nt = FF / 64; S.T.wide = 1;
          EpiResid E{HB2, HB, ss1, nullptr, nullptr, ws + WS_HBB, 0.5f}; pg8::gemm_phase(F.lds + RING_OFF, 64, FF, S, E, 32768); }
        if (MK_GATE_I8) { PHASE_END(1); quant_h_phase(F, HB, HB8, ASCALE); }
        PHASE_END(2);
        if (MK_DUP == 1) {
        { SchedPlain S; S.T.init(M, 2 * FF, G, ord); S.A = (const char*)HB8B; S.B = (const char*)(wl + OW_GU1); S.astep = (size_t)256 * D * MK_DUP1_STEPA; S.bstep = (size_t)256 * D * 2 * MK_DUP1_STEP; S.nt = D / 128;
          EpiSwiglu8 E{HID, ss0, ssb + (size_t)(l == 0 ? 0 : 4 * l - 1) * M, WSC + DEPTH * (NGATE + D) + (l * 2 + 0) * (2 * FF), F.lds + EPI_AREA_OFF}; pg8::gemm_phase<EpiSwiglu8, SchedPlain, true>(F.lds + RING_OFF, D / 2, D, S, E); }
        PHASE_END(1); }
        if (MK_DUP == 2) {
        { SchedPlain S; S.T.init(M, D, G, ord); S.A = (const char*)HID; S.B = (const char*)(wl + OW_D1); S.astep = (size_t)256 * FFP * 2; S.bstep = (size_t)256 * FF * 2; S.nt = FF / 64;
          EpiResid E{HB2, DUMB, ssb + (size_t)17 * M, nullptr, nullptr, nullptr, 0.5f}; pg8::gemm_phase(F.lds + RING_OFF, 64, FF, S, E, 32768); }
        PHASE_END(2); }
        if (PH(3)) {
        { SchedPlain S; S.T.init(M, 4096, G, ord); S.A = (const char*)(ws + WS_HBB); S.B = (const char*)(wl + OW_IN); S.astep = (size_t)256 * D * 2; S.bstep = (size_t)256 * D * 2; S.nt = D / 64; S.T.wide = MK_WIDE3;
          EpiWin E{ZH, ss1, F.lds + EPI_AREA_OFF, ssb + (size_t)(VS_SLOT0 + 2 * l) * M, 0}; pg8::gemm_phase(F.lds + RING_OFF, D, D, S, E); }
        if (MK_GATE_I8) {
          SchedPlain S; S.T.init(M, NGATE, G, ord); S.A = (const char*)HB8; S.B = (const char*)(wl + OW_IN) + (size_t)4096 * D * 2; S.astep = (size_t)256 * D; S.bstep = (size_t)256 * D * 2; S.nt = D / 128; S.T.wide = MK_WIDE3;
          EpiGate8 E{ws, F.lds + EPI_AREA_OFF, (unsigned)((const unsigned char*)ss1 - ws), (unsigned)(WS_SC + (size_t)(M + l * NGATE) * 4)}; pg8::gemm_phase<EpiGate8, SchedPlain, true>(F.lds + RING_OFF, D / 2, D, S, E);
        }
        }
        PHASE_END(3);
        if (MK_DUP == 3) {
        { SchedPlain S; S.T.init(M, NIN, G, ord); S.A = (const char*)HB; S.B = (const char*)(wl + OW_IN); S.astep = (size_t)256 * D * 2; S.bstep = (size_t)256 * D * 2; S.nt = D / 64;
          EpiWin E{ZH, ss1, F.lds + EPI_AREA_OFF, ssb + (size_t)(VS_SLOT0 + 2 * l) * M, 0}; pg8::gemm_phase(F.lds + RING_OFF, D, D, S, E); }
        PHASE_END(3); }
        if (PH(4))
        mixer_phase(F, ZH, YCAT, args.in.p[8] + l * 1024, args.in.p[9] + l * 1024, (const bf16*)(wl + OW_SGU), ssb + (size_t)(VS_SLOT0 + 2 * l) * M, args.in.p[11] + l * 1024, args.in.p[12] + l * 1536, (const bf16*)(wl + OW_POOL), args.in.p[14] + l * 512);
        PHASE_END(4);
        if (MK_DUP == 4) {
        mixer_phase(F, ZH, YCAT, args.in.p[8] + l * 1024, args.in.p[9] + l * 1024, (const bf16*)(wl + OW_SGU), ssb + (size_t)(VS_SLOT0 + 2 * l) * M, args.in.p[11] + l * 1024, args.in.p[12] + l * 1536, (const bf16*)(wl + OW_POOL), args.in.p[14] + l * 512);
        PHASE_END(4); }
        if (PH(5))
        { SchedBranch S; S.T.init(M, D, G, ord); S.A = (const char*)YCAT; S.B = (const char*)(wl + OW_BR); S.astep = (size_t)256 * D * 2; S.bstep = (size_t)256 * D * 2; S.T.wide = MK_WIDE5;
          EpiBranch E{ZH, MB}; pg8::gemm_phase(F.lds + RING_OFF, D, D, S, E); }
        PHASE_END(5);
        if (MK_DUP == 5) {
        { SchedBranch S; S.T.init(M, D, G, ord); S.A = (const char*)YCAT; S.B = (const char*)(wl + OW_BR); S.astep = (size_t)256 * D * 2; S.bstep = (size_t)256 * D * 2;
          EpiBranch E{ZH, MB}; pg8::gemm_phase(F.lds + RING_OFF, D, D, S, E); }
        PHASE_END(5); }
        if (PH(6))
        { SchedPlain S; S.T.init(M, D, G, ord); S.A = (const char*)MB; S.B = (const char*)(wl + OW_OUT); S.astep = (size_t)256 * D * 2; S.bstep = (size_t)256 * D * 2; S.nt = D / 64; S.T.wide = MK_WIDE5;
          EpiResid E{HB, HB, ss2, HB8B, ss1, nullptr, 1.0f}; pg8::gemm_phase(F.lds + RING_OFF, D, D, S, E); }
        PHASE_END(6);
        if (MK_DUP == 6) {
        { SchedPlain S; S.T.init(M, D, G, ord); S.A = (const char*)MB; S.B = (const char*)(wl + OW_OUT); S.astep = (size_t)256 * D * 2; S.bstep = (size_t)256 * D * 2; S.nt = D / 64;
          EpiResid E{HB, DUMB, ssb + (size_t)17 * M, nullptr, nullptr, nullptr, 1.0f}; pg8::gemm_phase(F.lds + RING_OFF, D, D, S, E); }
        PHASE_END(6); }
        if (PH(7))
        { SchedPlain S; S.T.init(M, 2 * FF, G, ord); S.A = (const char*)HB8B; S.B = (const char*)(wl + OW_GU2); S.astep = (size_t)256 * D; S.bstep = (size_t)256 * D * 2; S.nt = D / 128; S.T.wide = 1;
          EpiSwiglu8 E{HID, ss2, ss1, WSC + DEPTH * (NGATE + D) + (l * 2 + 1) * (2 * FF), F.lds + EPI_AREA_OFF}; pg8::gemm_phase<EpiSwiglu8, SchedPlain, true>(F.lds + RING_OFF, D / 2, D, S, E); }
        PHASE_END(7);
        if (PH(8))
        { SchedPlain S; S.T.init(M, D, G, ord); S.A = (const char*)HID; S.B = (const char*)(wl + OW_D2); S.astep = (size_t)256 * FFP * 2; S.bstep = (size_t)256 * FF * 2; S.nt = FF / 64; S.T.wide = 1;
          EpiResid E{HB, HB, ss3, HB8, ss2, nullptr, 0.5f}; pg8::gemm_phase(F.lds + RING_OFF, 64, FF, S, E, 32768); }
        PHASE_END(8);
        if (MK_DUP == 8) {
        { SchedPlain S; S.T.init(M, D, G, ord); S.A = (const char*)HID; S.B = (const char*)(wl + OW_D2); S.astep = (size_t)256 * FFP * 2; S.bstep = (size_t)256 * FF * 2; S.nt = FF / 64;
          EpiResid E{HB, DUMB, ssb + (size_t)17 * M, nullptr, nullptr, nullptr, 0.5f}; pg8::gemm_phase(F.lds + RING_OFF, 64, FF, S, E, 32768); }
        PHASE_END(8); }
        if (PH(9)) {
        { SchedPlain S; S.T.init(M, D, G, ord); S.A = (const char*)(ws + WS_PCAT) + (size_t)l * DPLE * 2; S.B = (const char*)(wl + OW_P) + (size_t)D * 2; S.astep = (size_t)256 * D * 2; S.bstep = (size_t)256 * (D + DPLE) * 2; S.nt = DPLE / 64; S.T.wide = MK_WIDE9;
          EpiProj E{PT}; pg8::gemm_phase(F.lds + RING_OFF, D, D + DPLE, S, E); }
        { SchedPlain S; S.T.init(M, D, G, ord); S.A = (const char*)HB8; S.B = (const char*)(wl + OW_P); S.astep = (size_t)256 * D; S.bstep = (size_t)256 * (D + DPLE) * 2; S.nt = D / 128; S.T.wide = MK_WIDE9;
          EpiPleGate8 E{HB, HB2, PT, ss3, ss2, WSC + DEPTH * NGATE + l * D, ss4, HB8B, F.lds + EPI_AREA_OFF}; pg8::gemm_phase<EpiPleGate8, SchedPlain, true>(F.lds + RING_OFF, D / 2, D + DPLE, S, E); }
        }
        PHASE_END(9);
    }
    if (PH(10))
    final_phase(F, HB2, out, args.in.p[26]);
    if (MK_TPROBE == 500) { const unsigned long long dc = __builtin_amdgcn_s_memtime() - tp_c0, dr = __builtin_amdgcn_s_memrealtime() - tp_r0; tp_acc = (dc * 2500ull) / dr; }
    if (MK_TPROBE == 999 && localmode) tp_acc = 50000ull;
    if (MK_TPROBE) { if (MK_TPROBE == 110) tp_acc += __builtin_amdgcn_s_memrealtime() - tp_prev;
#ifndef MK_TBLOCK
#define MK_TBLOCK 0
#endif
        if (blockIdx.x == MK_TBLOCK) { const unsigned long long t0_ = __builtin_amdgcn_s_memrealtime(); while (__builtin_amdgcn_s_memrealtime() - t0_ < (unsigned long long)MK_TAMP * tp_acc) __builtin_amdgcn_s_sleep(8); } }
#undef PHASE_END
#undef localmode
#undef ssb
#undef out
#undef HB
#undef HB2
#undef ZH
#undef YCAT
#undef MB
#undef PT
#undef HID
#undef HB8
#undef HB8B
#undef WSC
#undef ASCALE
#undef DUMF
#undef DUMB
#undef wl
#undef ss0
#undef ss1
#undef ss2
#undef ss3
#undef ss4
#undef LAUNDER_WS
}

extern "C" void kernel_launch(void* const* d_in, const int* in_sizes, int n_in, void* d_out, int out_size, void* d_ws, size_t ws_size, hipStream_t stream) {
    static int grid = 0;
    if (grid == 0) {
        if (n_in != 27 || out_size != M * D || ws_size < WS_END) { fprintf(stderr, "kernel_launch: unexpected shapes: n_in %d out %d ws %zu (need %zu); nothing launched\n", n_in, out_size, ws_size, (size_t)WS_END); grid = -1; return; }
        int dev = 0, cus = 0, per_cu = 0;
        if (hipGetDevice(&dev) != hipSuccess || hipDeviceGetAttribute(&cus, hipDeviceAttributeMultiprocessorCount, dev) != hipSuccess) { fprintf(stderr, "kernel_launch: device query failed\n"); grid = -1; return; }
        if (hipFuncSetAttribute((const void*)mk_fwd, hipFuncAttributeMaxDynamicSharedMemorySize, LDS_BYTES) != hipSuccess) { fprintf(stderr, "kernel_launch: hipFuncSetAttribute failed\n"); grid = -1; return; }
        if (hipOccupancyMaxActiveBlocksPerMultiprocessor(&per_cu, (const void*)mk_fwd, NWAVES * 64, LDS_BYTES) != hipSuccess || per_cu < 1) { fprintf(stderr, "kernel_launch: occupancy query reports %d blocks per CU\n", per_cu); }
        (void)hipGetLastError();
        grid = cus;
    }
    if (grid < 0) return;
    if (hipMemsetAsync((char*)d_ws + WS_CTL, 0, CTL_ZERO_BYTES, stream) != hipSuccess) { fprintf(stderr, "kernel_launch: memset failed\n"); return; }
    Args a{};
    for (int i = 0; i < 27; ++i) a.in.p[i] = (const float*)d_in[i];
    a.out = (float*)d_out; a.ws = (unsigned char*)d_ws;
    hipLaunchKernelGGL(mk_fwd, dim3(grid), dim3(NWAVES * 64), LDS_BYTES, stream, a);
    const hipError_t le = hipPeekAtLastError();
    if (le != hipSuccess) fprintf(stderr, "kernel_launch: launch failed: %s\n", hipGetErrorName(le));
}
```
